# Optimizing an MI355X kernel written in HIP

```python
import jax, jax.numpy as jnp
from jax import lax
import numpy as np

D_MODEL = 1024
BATCH = 32
SEQ = 2048
DEPTH = 2

D_MIX = D_MODEL
HEAD_DIM = 64
N_FOX_HEADS = 4
N_GMLP_GROUPS = 4
N_NSA_HEADS = 4
N_NSA_KV = 1
N_POOL_GROUPS = 4
W_FOX = N_FOX_HEADS * HEAD_DIM
W_GMLP = N_GMLP_GROUPS * HEAD_DIM
W_NSA = N_NSA_HEADS * HEAD_DIM
W_POOL = N_POOL_GROUPS * HEAD_DIM
W_NSA_KV = N_NSA_KV * HEAD_DIM
IN_SPLITS = (W_FOX, W_FOX, W_FOX, N_FOX_HEADS, W_GMLP, W_GMLP, W_NSA, W_NSA_KV, W_NSA_KV, W_NSA_KV, W_NSA_KV, W_NSA_KV, W_NSA_KV, 3 * N_NSA_HEADS, W_POOL)
N_IN = 3 * W_FOX + N_FOX_HEADS + 2 * W_GMLP + W_NSA + 6 * W_NSA_KV + 3 * N_NSA_HEADS + W_POOL
D_FF = 2816
ROPE_THETA = 500000.0
ROPE_DIM = HEAD_DIM // 4
Q_BLOCK = 128
NSA_Q_BLOCK = 64
GMLP_CHUNK = 128
CMP_LEN = 32
CMP_STRIDE = 16
CMP_HIDDEN = 256
SEL_LEN = 64
SEL_TOP = 16
WINDOW = 512
POOL_SIZES = (2, 4, 8, 16)
FFN_RES_WEIGHT = 0.5
EPS = 1e-6
NEG_INF = -1e30
SEL_FORCE = 1e3

kernel_name = 'hybrid_fox_gmlp_nsa_pool_macaron'

F32 = jnp.float32


def rms_norm(x, g):
    xf = x.astype(F32)
    y = xf * lax.rsqrt(jnp.mean(xf * xf, axis=-1, keepdims=True) + EPS)
    return (y * g.astype(F32)).astype(x.dtype)


def swiglu_ffn(x, g, w1, w3, w2):
    h = rms_norm(x, g)
    return (jax.nn.silu(h @ w1) * (h @ w3)) @ w2


def rope_partial(x, pos):
    half = ROPE_DIM // 2
    inv = ROPE_THETA ** (-jnp.arange(half, dtype=F32) * 2.0 / ROPE_DIM)
    ang = pos.astype(F32)[:, None] * inv[None, :]
    cos = jnp.cos(ang)[:, None, :].astype(x.dtype)
    sin = jnp.sin(ang)[:, None, :].astype(x.dtype)
    x1 = x[..., :half]
    x2 = x[..., half:ROPE_DIM]
    return jnp.concatenate([x1 * cos - x2 * sin, x2 * cos + x1 * sin, x[..., ROPE_DIM:]], axis=-1)


def split_mixing_columns(p):
    offs = []
    acc = 0
    for s in IN_SPLITS[:-1]:
        acc += s
        offs.append(acc)
    return jnp.split(p, offs, axis=-1)


def fox_mixer(q, k, v, f_logit, f_bias, g_q, g_k):
    B, T, H, Dh = q.shape
    q = rms_norm(q, g_q)
    k = rms_norm(k, g_k)
    log_f = jax.nn.log_sigmoid((f_logit + f_bias).astype(F32))
    c = jnp.cumsum(log_f, axis=1).transpose(0, 2, 1)
    scale = Dh ** -0.5
    kpos = jnp.arange(T)

    def block(i):
        t0 = i * Q_BLOCK
        q_i = lax.dynamic_slice_in_dim(q, t0, Q_BLOCK, axis=1)
        c_i = lax.dynamic_slice_in_dim(c, t0, Q_BLOCK, axis=2)
        s = jnp.einsum('bqhd,bshd->bhqs', q_i, k).astype(F32) * scale
        s = s + c_i[..., :, None] - c[:, :, None, :]
        qpos = t0 + jnp.arange(Q_BLOCK)
        s = jnp.where(kpos[None, :] <= qpos[:, None], s, NEG_INF)
        p = jax.nn.softmax(s, axis=-1).astype(v.dtype)
        return jnp.einsum('bhqs,bshd->bqhd', p, v)

    o = lax.map(block, jnp.arange(T // Q_BLOCK))
    return o.transpose(1, 0, 2, 3, 4).reshape(B, T, H * Dh)


def gmlp_mixer(u, v, g_v, w_s, b_s):
    B, T, W = u.shape
    G = N_GMLP_GROUPS
    Dg = W // G
    C = GMLP_CHUNK
    u = jax.nn.gelu(u)
    v = rms_norm(jax.nn.gelu(v).reshape(B, T, G, Dg), g_v.reshape(G, Dg))
    vc = v.reshape(B, T // C, C, G, Dg)
    w = w_s * jnp.tril(jnp.ones((C, C), w_s.dtype))
    s = jnp.einsum('gts,bcsgd->bctgd', w, vc) + b_s.T[:, :, None]
    return u * s.reshape(B, T, W)


def compress_kv(kv, pos_emb, w1, w2):
    B, T, Hk, Dh = kv.shape
    nc = (T - CMP_LEN) // CMP_STRIDE + 1
    idx = jnp.arange(nc)[:, None] * CMP_STRIDE + jnp.arange(CMP_LEN)[None, :]
    blocks = kv[:, idx] + pos_emb[None, None, :, None, :]
    flat = blocks.transpose(0, 1, 3, 2, 4).reshape(B, nc, Hk, CMP_LEN * Dh)
    return jax.nn.gelu(flat @ w1) @ w2


def cmp_to_sel_overlap(nc, nsel):
    cs = np.arange(nc) * CMP_STRIDE
    ce = cs + CMP_LEN
    ss = np.arange(nsel) * SEL_LEN
    se = ss + SEL_LEN
    ov = np.clip(np.minimum(ce[:, None], se[None, :]) - np.maximum(cs[:, None], ss[None, :]), 0, None)
    return jnp.asarray(ov / CMP_LEN, dtype=F32)


def nsa_mixer(q, kc, vc, ks, vs, kw, vw, gate_logit, gate_b, g_q, g_kc, g_ks, g_kw,
              pos_k, k_w1, k_w2, pos_v, v_w1, v_w2):
    B, T = q.shape[:2]
    H, Hk, Dh = N_NSA_HEADS, N_NSA_KV, HEAD_DIM
    Hg = H // Hk
    Qb = NSA_Q_BLOCK
    scale = Dh ** -0.5
    pos = jnp.arange(T)
    q = rope_partial(rms_norm(q.reshape(B, T, H, Dh), g_q), pos).reshape(B, T, Hk, Hg, Dh)
    kc, vc, ks, vs, kw, vw = [a.reshape(B, T, Hk, Dh) for a in (kc, vc, ks, vs, kw, vw)]

    nc = (T - CMP_LEN) // CMP_STRIDE + 1
    cmp_end = jnp.arange(nc) * CMP_STRIDE + CMP_LEN - 1
    k_cmp = rope_partial(rms_norm(compress_kv(kc, pos_k, k_w1, k_w2), g_kc), cmp_end)
    v_cmp = compress_kv(vc, pos_v, v_w1, v_w2)
    s = jnp.einsum('btghd,bngd->bghtn', q, k_cmp).astype(F32) * scale
    m_cmp = cmp_end[None, :] <= pos[:, None]
    p_cmp = jnp.where(m_cmp, jax.nn.softmax(jnp.where(m_cmp, s, NEG_INF), axis=-1), 0.0)
    o_cmp = jnp.einsum('bghtn,bngd->btghd', p_cmp.astype(v_cmp.dtype), v_cmp)

    nsel = T // SEL_LEN
    n_top = min(SEL_TOP, nsel)
    imp = jnp.einsum('bghtn,nj->bgtj', p_cmp, cmp_to_sel_overlap(nc, nsel))
    blk = jnp.arange(nsel)[None, :]
    cur = (pos // SEL_LEN)[:, None]
    forced = ((blk == 0) | (blk == cur) | (blk == cur - 1)).astype(F32)
    imp = jnp.where(blk <= cur, imp + SEL_FORCE * forced, NEG_INF)
    top_val, top_idx = lax.top_k(imp, n_top)
    top_ok = top_val > NEG_INF * 0.5

    ks = rope_partial(rms_norm(ks, g_ks), pos)
    ks_blocks = ks.reshape(B, nsel, SEL_LEN, Hk, Dh).transpose(0, 3, 1, 2, 4)
    vs_blocks = vs.reshape(B, nsel, SEL_LEN, Hk, Dh).transpose(0, 3, 1, 2, 4)
    kw_pad = jnp.pad(rope_partial(rms_norm(kw, g_kw), pos), ((0, 0), (WINDOW, 0), (0, 0), (0, 0)))
    vw_pad = jnp.pad(vw, ((0, 0), (WINDOW, 0), (0, 0), (0, 0)))
    bi = jnp.arange(B)[:, None, None, None]
    gi = jnp.arange(Hk)[None, :, None, None]
    m_len = n_top * SEL_LEN

    def block(i):
        t0 = i * Qb
        q_i = lax.dynamic_slice_in_dim(q, t0, Qb, axis=1)
        t_i = t0 + jnp.arange(Qb)
        idx = lax.dynamic_slice_in_dim(top_idx, t0, Qb, axis=2)
        ok = lax.dynamic_slice_in_dim(top_ok, t0, Qb, axis=2)
        k_g = ks_blocks[bi, gi, idx].reshape(B, Hk, Qb, m_len, Dh)
        v_g = vs_blocks[bi, gi, idx].reshape(B, Hk, Qb, m_len, Dh)
        kpos = (idx[..., None] * SEL_LEN + jnp.arange(SEL_LEN)).reshape(B, Hk, Qb, m_len)
        m_s = jnp.repeat(ok, SEL_LEN, axis=-1) & (kpos <= t_i[None, None, :, None])
        s = jnp.einsum('bqghd,bgqmd->bghqm', q_i, k_g).astype(F32) * scale
        p = jax.nn.softmax(jnp.where(m_s[:, :, None], s, NEG_INF), axis=-1)
        o_s = jnp.einsum('bghqm,bgqmd->bqghd', p.astype(v_g.dtype), v_g)
        kw_i = lax.dynamic_slice_in_dim(kw_pad, t0, WINDOW + Qb, axis=1)
        vw_i = lax.dynamic_slice_in_dim(vw_pad, t0, WINDOW + Qb, axis=1)
        wpos = t0 - WINDOW + jnp.arange(WINDOW + Qb)
        d = t_i[:, None] - wpos[None, :]
        m_w = (d >= 0) & (d < WINDOW) & (wpos[None, :] >= 0)
        s = jnp.einsum('bqghd,bsgd->bghqs', q_i, kw_i).astype(F32) * scale
        p = jax.nn.softmax(jnp.where(m_w, s, NEG_INF), axis=-1)
        o_w = jnp.einsum('bghqs,bsgd->bqghd', p.astype(vw_i.dtype), vw_i)
        return o_s, o_w

    o_s, o_w = lax.map(block, jnp.arange(T // Qb))
    o_s = o_s.transpose(1, 0, 2, 3, 4, 5).reshape(B, T, Hk, Hg, Dh)
    o_w = o_w.transpose(1, 0, 2, 3, 4, 5).reshape(B, T, Hk, Hg, Dh)
    g = jax.nn.sigmoid((gate_logit + gate_b).astype(F32)).astype(q.dtype).reshape(B, T, Hk, Hg, 3)
    o = g[..., 0:1] * o_cmp + g[..., 1:2] * o_s + g[..., 2:3] * o_w
    return o.reshape(B, T, H * Dh)


def pool_mixer(z, w_p, scale):
    B, T, W = z.shape
    G = N_POOL_GROUPS
    Dg = W // G
    zf = z.astype(F32)
    cs = jnp.cumsum(zf, axis=1)
    cs = jnp.concatenate([jnp.zeros_like(cs[:, :1]), cs], axis=1)
    win = jnp.repeat(jnp.array(POOL_SIZES, jnp.int32), Dg)
    t = jnp.arange(T)[:, None]
    lo = jnp.maximum(t + 1 - win[None, :], 0)
    lo_sum = jnp.take_along_axis(cs, jnp.broadcast_to(lo[None], (B, T, W)), axis=1)
    cnt = jnp.minimum(t + 1, win[None, :]).astype(F32)
    pooled = ((cs[:, 1:] - lo_sum) / cnt - zf).astype(z.dtype).reshape(B, T, G, Dg)
    y = jnp.einsum('btgd,gde->btge', pooled, w_p)
    return y.reshape(B, T, W) * scale


def setup_inputs(seed: int = 0) -> dict:
    key = jax.random.key(seed)
    ks = list(jax.random.split(key, 40))
    L = DEPTH

    def nrm(shape, scale):
        return jax.random.normal(ks.pop(), shape, F32) * scale

    def gain(shape):
        return 1.0 + 0.02 * jax.random.normal(ks.pop(), shape, F32)

    return {
        'x': nrm((BATCH, SEQ, D_MODEL), 1.0),
        'ffn1_norm': gain((L, D_MODEL)),
        'ffn1_w1': nrm((L, D_MODEL, D_FF), D_MODEL ** -0.5),
        'ffn1_w3': nrm((L, D_MODEL, D_FF), D_MODEL ** -0.5),
        'ffn1_w2': nrm((L, D_FF, D_MODEL), D_FF ** -0.5),
        'mix_norm': gain((L, D_MODEL)),
        'w_in': nrm((L, D_MODEL, N_IN), D_MODEL ** -0.5),
        'w_out': nrm((L, D_MIX, D_MODEL), D_MIX ** -0.5),
        'fox_f_bias': jax.random.uniform(ks.pop(), (L, N_FOX_HEADS), F32, 1.0, 4.0),
        'fox_q_norm': gain((L, HEAD_DIM)),
        'fox_k_norm': gain((L, HEAD_DIM)),
        'gmlp_v_norm': gain((L, W_GMLP)),
        'gmlp_w_s': nrm((L, N_GMLP_GROUPS, GMLP_CHUNK, GMLP_CHUNK), GMLP_CHUNK ** -0.5),
        'gmlp_b_s': gain((L, N_GMLP_GROUPS, GMLP_CHUNK)),
        'nsa_q_norm': gain((L, HEAD_DIM)),
        'nsa_kc_norm': gain((L, HEAD_DIM)),
        'nsa_ks_norm': gain((L, HEAD_DIM)),
        'nsa_kw_norm': gain((L, HEAD_DIM)),
        'nsa_cmp_pos_k': nrm((L, CMP_LEN, HEAD_DIM), 0.1),
        'nsa_cmp_k_w1': nrm((L, CMP_LEN * HEAD_DIM, CMP_HIDDEN), (CMP_LEN * HEAD_DIM) ** -0.5),
        'nsa_cmp_k_w2': nrm((L, CMP_HIDDEN, HEAD_DIM), CMP_HIDDEN ** -0.5),
        'nsa_cmp_pos_v': nrm((L, CMP_LEN, HEAD_DIM), 0.1),
        'nsa_cmp_v_w1': nrm((L, CMP_LEN * HEAD_DIM, CMP_HIDDEN), (CMP_LEN * HEAD_DIM) ** -0.5),
        'nsa_cmp_v_w2': nrm((L, CMP_HIDDEN, HEAD_DIM), CMP_HIDDEN ** -0.5),
        'nsa_gate_bias': nrm((L, 3 * N_NSA_HEADS), 0.02),
        'pool_w': nrm((L, N_POOL_GROUPS, W_POOL // N_POOL_GROUPS, W_POOL // N_POOL_GROUPS), (W_POOL // N_POOL_GROUPS) ** -0.5),
        'pool_scale': gain((L, W_POOL)),
        'ffn2_norm': gain((L, D_MODEL)),
        'ffn2_w1': nrm((L, D_MODEL, D_FF), D_MODEL ** -0.5),
        'ffn2_w3': nrm((L, D_MODEL, D_FF), D_MODEL ** -0.5),
        'ffn2_w2': nrm((L, D_FF, D_MODEL), D_FF ** -0.5),
    }


def reference(x, ffn1_norm, ffn1_w1, ffn1_w3, ffn1_w2, mix_norm, w_in, w_out,
              fox_f_bias, fox_q_norm, fox_k_norm, gmlp_v_norm, gmlp_w_s, gmlp_b_s,
              nsa_q_norm, nsa_kc_norm, nsa_ks_norm, nsa_kw_norm,
              nsa_cmp_pos_k, nsa_cmp_k_w1, nsa_cmp_k_w2, nsa_cmp_pos_v, nsa_cmp_v_w1, nsa_cmp_v_w2,
              nsa_gate_bias, pool_w, pool_scale, ffn2_norm, ffn2_w1, ffn2_w3, ffn2_w2):
    B, T, _ = x.shape
    for l in range(DEPTH):
        x = x + FFN_RES_WEIGHT * swiglu_ffn(x, ffn1_norm[l], ffn1_w1[l], ffn1_w3[l], ffn1_w2[l])
        h = rms_norm(x, mix_norm[l])
        (fq, fk, fv, ff, gu, gv, nq, nkc, nvc, nks, nvs, nkw, nvw, ng, pz) = split_mixing_columns(h @ w_in[l])
        fshape = (B, T, N_FOX_HEADS, HEAD_DIM)
        o_a = fox_mixer(fq.reshape(fshape), fk.reshape(fshape), fv.reshape(fshape), ff,
                        fox_f_bias[l], fox_q_norm[l], fox_k_norm[l])
        o_b = gmlp_mixer(gu, gv, gmlp_v_norm[l], gmlp_w_s[l], gmlp_b_s[l])
        o_c = nsa_mixer(nq, nkc, nvc, nks, nvs, nkw, nvw, ng, nsa_gate_bias[l],
                        nsa_q_norm[l], nsa_kc_norm[l], nsa_ks_norm[l], nsa_kw_norm[l],
                        nsa_cmp_pos_k[l], nsa_cmp_k_w1[l], nsa_cmp_k_w2[l],
                        nsa_cmp_pos_v[l], nsa_cmp_v_w1[l], nsa_cmp_v_w2[l])
        o_d = pool_mixer(pz, pool_w[l], pool_scale[l])
        x = x + jnp.concatenate([o_a, o_b, o_c, o_d], axis=-1) @ w_out[l]
        x = x + FFN_RES_WEIGHT * swiglu_ffn(x, ffn2_norm[l], ffn2_w1[l], ffn2_w3[l], ffn2_w2[l])
    return x
```

```cpp
#include <hip/hip_runtime.h>
#include <hip/hip_cooperative_groups.h>
#include <cstdio>
#include <cstdint>
namespace cg = cooperative_groups;
__device__ __forceinline__ int ltid() { int t = threadIdx.x; asm volatile("" : "+v"(t)); return t; }
namespace pg8 {
#define PG8_LAS __attribute__((address_space(3)))
typedef unsigned short bf16_t;
typedef short bf16x8 __attribute__((ext_vector_type(8)));
typedef float f32x4 __attribute__((ext_vector_type(4)));
typedef unsigned u32x4 __attribute__((ext_vector_type(4)));
constexpr int BM = 256, BK = 64, HALF = 128, HTB = HALF * BK * 2  , STAGE_BYTES = 8 * HTB, NXCD = 8, WGM = 8;

__host__ __device__ __forceinline__ int lds_byte(int r, int c) { const int st = (r >> 4) * 2 + (c >> 5), rr = r & 15, cc = c & 31, ob = rr * 64 + cc * 2; return st * 1024 + (ob ^ (((ob >> 9) & 1) << 5)); }
__host__ __device__ __forceinline__ void stage_rc(int b, int& R, int& C) { const int st = b / 1024, sb = b % 1024, swz = sb ^ (((sb >> 9) & 1) << 5); R = (st >> 1) * 16 + swz / 64; C = (st & 1) * 32 + (swz % 64) / 2; }
__host__ __device__ __forceinline__ int perm32(int rho) { const int n = rho >> 4, i = rho & 15; return 8 * (i >> 2) + 4 * n + (i & 3); }

struct Unit { int pm, pn; };
struct Gemm { const bf16_t* A; const bf16_t* Bt; int M, N, K; };

struct StaticOrder {
    int nM, nN, nwg, G, c;
    __host__ __device__ void init(int M, int N, int G_, int c_) { nM = M / BM; nN = N / BM; nwg = nM * nN; G = G_; c = c_; }
    __host__ __device__ bool next(int i, Unit& u) const {
        const long L = (long)i * G + c; if (L >= nwg) return false;
        int wgid = (int)L; { const int q = nwg / NXCD, r = nwg % NXCD, xcd = wgid % NXCD, off = wgid / NXCD; wgid = (xcd < r ? xcd * (q + 1) : r * (q + 1) + (xcd - r) * q) + off; }
        const int nig = WGM * nN, gid = wgid / nig, fm = gid * WGM, gsz = (nM - fm) < WGM ? (nM - fm) : WGM;
        u.pm = fm + ((wgid % nig) % gsz); u.pn = (wgid % nig) / gsz; return true;
    }
    __device__ __forceinline__ void a_ready(const Unit&) const {}
    __device__ __forceinline__ void done(const Unit&) const {}
};

__device__ __forceinline__ unsigned cvt_pk_bf16(float lo, float hi) { unsigned r; asm volatile("v_cvt_pk_bf16_f32 %0, %1, %2" : "=v"(r) : "v"(lo), "v"(hi)); return r; }
template <class Epi, class Sched, bool ALIGN_EPI = false, bool SP2 = false>
__device__ __forceinline__ void gemm_phase(PG8_LAS unsigned char* lds, const Gemm g, const Sched& S, const Epi& E) {
    const int tid = ltid(), wid = __builtin_amdgcn_readfirstlane(tid >> 6), lane = tid & 63, wr = wid >> 2, wc = wid & 3, fr = lane & 15, fq = lane >> 4;
    const int K = g.K, nt = K / BK;
    unsigned voffA[2], voffB[2];
#pragma unroll
    for (int i = 0; i < 2; ++i) { int R, C; stage_rc(tid * 16 + i * 8192, R, C); const int Rb = Epi::PERM ? ((R & ~31) + perm32(R & 31)) : R;
        voffA[i] = (unsigned)(R * 64 + C) * 2u; voffB[i] = (unsigned)(Rb * 64 + C) * 2u; }
    const size_t kstepA = (size_t)g.M * 128, kstepB = (size_t)g.N * 128;
    const size_t hstep = (size_t)HALF * 128;
    const size_t tstep = 2 * hstep;
    const unsigned ldsw = (unsigned)wid * 1024u;
    const int aoff = lds_byte(wr * 64 + fr, fq * 8), boff = lds_byte(wc * 32 + fr, fq * 8);
#define PG8_SA(b, h) (((b) * 2 + (h)) * HTB)
#define PG8_SB(b, h) ((4 + (b) * 2 + (h)) * HTB)
#define PG8_STAGE(bufoff, gbase, voff) do { _Pragma("unroll") for (int _i = 0; _i < 2; ++_i) \
        __builtin_amdgcn_global_load_lds((const unsigned*)((const char*)(gbase) + (voff)[_i]), (PG8_LAS unsigned*)(lds + (bufoff) + ldsw + _i * 8192), 16, 0, 0); } while (0)
#define PG8_LDA(dst, b, h) do { _Pragma("unroll") for (int m = 0; m < 4; ++m) _Pragma("unroll") for (int k = 0; k < 2; ++k) dst[m][k] = *(const PG8_LAS bf16x8*)(lds + PG8_SA(b, h) + aoff + m * 2048 + k * 1024); } while (0)
#define PG8_LDB(dst, b, h) do { _Pragma("unroll") for (int n = 0; n < 2; ++n) _Pragma("unroll") for (int k = 0; k < 2; ++k) dst[n][k] = *(const PG8_LAS bf16x8*)(lds + PG8_SB(b, h) + boff + n * 2048 + k * 1024); } while (0)
#define PG8_MMA(ai, bj, At, Bt) do { __builtin_amdgcn_s_setprio(1); _Pragma("unroll") for (int m = 0; m < 4; ++m) _Pragma("unroll") for (int n = 0; n < 2; ++n) _Pragma("unroll") for (int k = 0; k < 2; ++k) \
        acc[ai][bj][m][n] = __builtin_amdgcn_mfma_f32_16x16x32_bf16(Bt[n][k], At[m][k], acc[ai][bj][m][n], 0, 0, 0); __builtin_amdgcn_s_setprio(0); } while (0)
#define PG8_WAIT_V(n) asm volatile("s_waitcnt vmcnt(" #n ")" ::: "memory")
#define PG8_WAIT_L(n) asm volatile("s_waitcnt lgkmcnt(" #n ")" ::: "memory")
#define PG8_BAR __builtin_amdgcn_s_barrier()
#define PG8_SCHED __builtin_amdgcn_sched_barrier(0)
    Unit cur, nxt; int ui = 0;
    if (!S.next(0, cur)) return;
    f32x4 acc[2][2][4][2];
#pragma unroll
    for (int a = 0; a < 2; ++a)
#pragma unroll
        for (int b = 0; b < 2; ++b)
#pragma unroll
            for (int m = 0; m < 4; ++m)
#pragma unroll
                for (int n = 0; n < 2; ++n) acc[a][b][m][n] = (f32x4){0.f, 0.f, 0.f, 0.f};
    bf16x8 At[4][2], B0[2][2], B1[2][2];
    const char* cA = (const char*)g.A + (size_t)cur.pm * tstep; const char* cB = (const char*)g.Bt + (size_t)cur.pn * tstep;
    S.a_ready(cur);
    if constexpr (SP2) {
        PG8_STAGE(PG8_SB(0, 0), cB, voffB); PG8_STAGE(PG8_SB(0, 1), cB + hstep, voffB); PG8_STAGE(PG8_SA(0, 0), cA, voffA); PG8_STAGE(PG8_SA(0, 1), cA + hstep, voffA);
        if (wr == 1) PG8_BAR;
        PG8_WAIT_V(2); PG8_BAR;
        PG8_STAGE(PG8_SB(1, 0), cB + kstepB, voffB); PG8_STAGE(PG8_SA(1, 0), cA + kstepA, voffA); PG8_STAGE(PG8_SB(1, 1), cB + hstep + kstepB, voffB);
        PG8_WAIT_V(6); PG8_BAR;
    } else {
        PG8_STAGE(PG8_SB(0, 0), cB, voffB); PG8_STAGE(PG8_SA(0, 0), cA, voffA); PG8_STAGE(PG8_SB(0, 1), cB + hstep, voffB); PG8_STAGE(PG8_SA(0, 1), cA + hstep, voffA);
        if (wr == 1) PG8_BAR;
        PG8_WAIT_V(4); PG8_BAR;
        PG8_STAGE(PG8_SB(1, 0), cB + kstepB, voffB); PG8_STAGE(PG8_SA(1, 0), cA + kstepA, voffA); PG8_STAGE(PG8_SB(1, 1), cB + hstep + kstepB, voffB);
        PG8_WAIT_V(6); PG8_BAR;
    }
    for (;;) {
        const bool has_next = S.next(ui + 1, nxt);
        const char* nA = has_next ? (const char*)g.A + (size_t)nxt.pm * tstep : cA; const char* nB = has_next ? (const char*)g.Bt + (size_t)nxt.pn * tstep : cB;
        for (int t = 0; t < nt; t += 2) {
            const bool last = (t == nt - 2);
            const char* a1 = cA + (size_t)(t + 1) * kstepA;
            const char* a2 = last ? nA : cA + (size_t)(t + 2) * kstepA; const char* b2 = last ? nB : cB + (size_t)(t + 2) * kstepB;
            const char* a3 = a2 + kstepA; const char* b3 = b2 + kstepB;
            if (last && has_next) S.a_ready(nxt);
            if constexpr (SP2) {
            PG8_LDB(B0, 0, 0); PG8_LDB(B1, 0, 1); PG8_SCHED; PG8_LDA(At, 0, 0); PG8_STAGE(PG8_SA(1, 1), a1 + hstep, voffA);
            PG8_WAIT_V(8); PG8_WAIT_L(0); PG8_BAR; PG8_MMA(0, 0, At, B0); PG8_MMA(0, 1, At, B1); PG8_BAR; PG8_SCHED;
            PG8_LDA(At, 0, 1); PG8_STAGE(PG8_SB(0, 0), b2, voffB); PG8_STAGE(PG8_SB(0, 1), b2 + hstep, voffB); PG8_STAGE(PG8_SA(0, 0), a2, voffA);
            PG8_WAIT_V(8); PG8_WAIT_L(0); PG8_BAR; PG8_MMA(1, 0, At, B0); PG8_MMA(1, 1, At, B1); PG8_BAR; PG8_SCHED;
            PG8_LDB(B0, 1, 0); PG8_LDB(B1, 1, 1); PG8_SCHED; PG8_LDA(At, 1, 0); PG8_STAGE(PG8_SA(0, 1), a2 + hstep, voffA);
            PG8_WAIT_V(8); PG8_WAIT_L(0); PG8_BAR; PG8_MMA(0, 0, At, B0); PG8_MMA(0, 1, At, B1); PG8_BAR; PG8_SCHED;
            PG8_LDA(At, 1, 1); PG8_STAGE(PG8_SB(1, 0), b3, voffB); PG8_STAGE(PG8_SB(1, 1), b3 + hstep, voffB); PG8_STAGE(PG8_SA(1, 0), a3, voffA);
            PG8_WAIT_V(8); PG8_WAIT_L(0); PG8_BAR; PG8_MMA(1, 0, At, B0); PG8_MMA(1, 1, At, B1); PG8_BAR; PG8_SCHED;
            } else {
            PG8_LDB(B0, 0, 0); PG8_SCHED; PG8_LDA(At, 0, 0); PG8_STAGE(PG8_SA(1, 1), a1 + hstep, voffA);
            PG8_WAIT_L(8); PG8_BAR; PG8_WAIT_L(0); PG8_MMA(0, 0, At, B0); PG8_BAR; PG8_SCHED;
            PG8_LDB(B1, 0, 1); PG8_STAGE(PG8_SB(0, 0), b2, voffB);
            PG8_BAR; PG8_WAIT_L(0); PG8_MMA(0, 1, At, B1); PG8_BAR;
            PG8_LDA(At, 0, 1); PG8_STAGE(PG8_SA(0, 0), a2, voffA);
            PG8_BAR; PG8_WAIT_L(0); PG8_MMA(1, 0, At, B0); PG8_BAR; PG8_SCHED;
            PG8_STAGE(PG8_SB(0, 1), b2 + hstep, voffB);
            PG8_WAIT_V(6); PG8_BAR; PG8_MMA(1, 1, At, B1); PG8_BAR;
            PG8_LDB(B0, 1, 0); PG8_SCHED; PG8_LDA(At, 1, 0); PG8_STAGE(PG8_SA(0, 1), a2 + hstep, voffA);
            PG8_WAIT_L(8); PG8_BAR; PG8_WAIT_L(0); PG8_MMA(0, 0, At, B0); PG8_BAR; PG8_SCHED;
            PG8_LDB(B1, 1, 1); PG8_STAGE(PG8_SB(1, 0), b3, voffB);
            PG8_BAR; PG8_WAIT_L(0); PG8_MMA(0, 1, At, B1); PG8_BAR;
            PG8_LDA(At, 1, 1); PG8_STAGE(PG8_SA(1, 0), a3, voffA);
            PG8_BAR; PG8_WAIT_L(0); PG8_MMA(1, 0, At, B0); PG8_BAR; PG8_SCHED;
            PG8_STAGE(PG8_SB(1, 1), b3 + hstep, voffB);
            PG8_WAIT_V(6); PG8_BAR; PG8_MMA(1, 1, At, B1); PG8_BAR;
            }
        }
        if constexpr (ALIGN_EPI) { if (wr == 0) PG8_BAR; }
        if constexpr (!Epi::AFTER_DRAIN) { E(acc, cur, wr, wc, fr, fq); S.done(cur); }
        if (!has_next) break;
#pragma unroll
        for (int a = 0; a < 2; ++a)
#pragma unroll
            for (int b = 0; b < 2; ++b)
#pragma unroll
                for (int m = 0; m < 4; ++m)
#pragma unroll
                    for (int n = 0; n < 2; ++n) acc[a][b][m][n] = (f32x4){0.f, 0.f, 0.f, 0.f};
        cur = nxt; cA = nA; cB = nB; ++ui;
        if constexpr (ALIGN_EPI) { if (wr == 1) PG8_BAR; }
    }
    PG8_WAIT_V(0);
    if constexpr (!ALIGN_EPI) { if (wr == 0) PG8_BAR; }
    PG8_BAR;
    if constexpr (Epi::AFTER_DRAIN) { E.fused(acc, cur, wr, wc, fr, fq, lds, wid, lane); S.done(cur); }
#undef PG8_SA
#undef PG8_SB
#undef PG8_STAGE
#undef PG8_LDA
#undef PG8_LDB
#undef PG8_MMA
#undef PG8_WAIT_V
#undef PG8_WAIT_L
#undef PG8_BAR
#undef PG8_SCHED
}
}

using pg8::bf16_t; using pg8::bf16x8; using pg8::f32x4; using pg8::u32x4;
#define LAS __attribute__((address_space(3)))
typedef short s16x4 __attribute__((ext_vector_type(4)));
typedef float f32x16 __attribute__((ext_vector_type(16)));
typedef unsigned u32x2 __attribute__((ext_vector_type(2)));
#define MFMA32(a, b, c) __builtin_amdgcn_mfma_f32_32x32x16_bf16((a), (b), (c), 0, 0, 0)
#define MFMA16(a, b, c) __builtin_amdgcn_mfma_f32_16x16x32_bf16((a), (b), (c), 0, 0, 0)
#define LDS_WAIT() asm volatile("s_waitcnt lgkmcnt(0)" ::: "memory")
#define SCHED_FENCE() __builtin_amdgcn_sched_barrier(0)

#ifndef DUP
#define DUP 0
#endif
constexpr int BATCH = 32, SEQ = 2048, DM = 1024, MTOK = BATCH * SEQ, DFF = 2816, NIN = 2192, NINP = 2304, DEPTH = 2, NTHR = 512, NWAVE = 8;
constexpr float EPS = 1e-6f, LOG2E = 1.4426950408889634f, QSCALE = 0.125f * LOG2E;
constexpr int C_FQ = 0, C_FK = 256, C_FV = 512, C_GU = 768, C_GV = 1024, C_NQ = 1280, C_NKC = 1536, C_NVC = 1600, C_NKS = 1664, C_NVS = 1728, C_NKW = 1792, C_NVW = 1856, C_PZ = 1920, C_FF = 2176, C_NG = 2180;
constexpr int LDS_BYTES = 147456;
constexpr size_t KiB = 1024, MiB = 1u << 20;
constexpr size_t WL_W13A = 0, WL_W2A = 11 * MiB, WL_WIN = WL_W2A + 5632 * KiB, WL_WOUT = 21 * MiB, WL_W13B = 23 * MiB, WL_W2B = 34 * MiB, WL_CK1 = WL_W2B + 5632 * KiB, WL_CV1 = WL_CK1 + MiB,
                 WL_CK2 = WL_CV1 + MiB, WL_CV2 = WL_CK2 + 32 * KiB, WL_GWS = WL_CV2 + 32 * KiB, WL_PWT = WL_GWS + 128 * KiB, WL_STRIDE = 42 * MiB;
static_assert(WL_PWT + 32 * KiB <= WL_STRIDE, "weights map");
constexpr size_t WS_W = 0, WS_XB = 84 * MiB, WS_SS = 212 * MiB, WS_R1 = 214 * MiB, WS_R2 = 566 * MiB;
constexpr size_t WS_FQ = WS_R2, WS_FK = WS_FQ + 32 * MiB, WS_FVT = WS_FK + 32 * MiB, WS_NQ = WS_FVT + 32 * MiB, WS_NKS = WS_NQ + 32 * MiB, WS_NVST = WS_NKS + 8 * MiB, WS_NKW = WS_NVST + 8 * MiB,
                 WS_NVWT = WS_NKW + 8 * MiB, WS_FC = WS_NVWT + 8 * MiB, WS_NG = WS_FC + MiB, WS_KCMP = WS_NG + 3 * MiB, WS_VCMPT = WS_KCMP + 512 * KiB, WS_O = WS_VCMPT + 512 * KiB, WS_END = WS_O + 128 * MiB;
constexpr size_t WS_CTL = WS_END, WS_CTL_BYTES = 16384, WS_FFB = WS_END + MiB, WS_SSP = WS_FFB + MiB, WS_ROPE = WS_SSP + 24 * MiB, WS_TOTAL = WS_ROPE + MiB;
static_assert(WS_TOTAL <= 1024 * MiB && 3456 * 4 <= (int)WS_CTL_BYTES, "ws map");

struct Args { const float* in[31]; float* out; unsigned char* ws; };

__device__ __forceinline__ unsigned pkbf(float lo, float hi) {
    typedef float f2 __attribute__((ext_vector_type(2))); typedef __bf16 b2 __attribute__((ext_vector_type(2)));
    f2 v = {lo, hi}; b2 b = __builtin_convertvector(v, b2); return __builtin_bit_cast(unsigned, b);
}
__device__ __forceinline__ size_t blk(size_t r, int k, size_t rows) { return ((size_t)(k >> 6) * rows + r) * 64 + (k & 63); }
__device__ __forceinline__ float bflo(unsigned u) { return __uint_as_float(u << 16); }
__device__ __forceinline__ float bfhi(unsigned u) { return __uint_as_float(u & 0xffff0000u); }
__device__ __forceinline__ float gelu_t(float x) { const float y = 0.7978845608028654f * (x + 0.044715f * x * x * x); return x * __builtin_amdgcn_rcpf(1.f + __expf(-2.f * y)); }
__device__ __forceinline__ float x32_max(float x) { auto t = __builtin_amdgcn_permlane32_swap(__float_as_uint(x), __float_as_uint(x), false, false); return fmaxf(__uint_as_float(t[0]), __uint_as_float(t[1])); }
__device__ __forceinline__ float x32_sum(float x) { auto t = __builtin_amdgcn_permlane32_swap(__float_as_uint(x), __float_as_uint(x), false, false); return __uint_as_float(t[0]) + __uint_as_float(t[1]); }
__device__ __forceinline__ float x1632_sum(float x) {
    auto s = __builtin_amdgcn_permlane16_swap(__float_as_uint(x), __float_as_uint(x), false, false); x = __uint_as_float(s[0]) + __uint_as_float(s[1]);
    auto t = __builtin_amdgcn_permlane32_swap(__float_as_uint(x), __float_as_uint(x), false, false); return __uint_as_float(t[0]) + __uint_as_float(t[1]); }
__device__ __forceinline__ float wave_sum(float v) {
#pragma unroll
    for (int o = 1; o < 64; o <<= 1) v += __shfl_xor(v, o);
    return v;
}

#define XB_TMO      128
#define XB_XCNT(j)  (256  + 64 * (j))
#define XB_XSUB(j)  (1280 + 64 * (j))
#define XB_XGEN(j)  (2304 + 64 * (j))
#define XB_TOP      3328
#define XB_TOPGEN   3392
#define XCD_BAR_WORDS 3456
#define XB_SPIN_CAP (1u << 18)

__device__ __forceinline__ unsigned xb_ld(unsigned* p)              { return __hip_atomic_load(p, __ATOMIC_RELAXED, __HIP_MEMORY_SCOPE_AGENT); }
__device__ __forceinline__ unsigned xb_add(unsigned* p, unsigned v) { return __hip_atomic_fetch_add(p, v, __ATOMIC_RELAXED, __HIP_MEMORY_SCOPE_AGENT); }
__device__ __forceinline__ unsigned xb_xcc_id() { return (unsigned)__builtin_amdgcn_s_getreg((3 << 11) | 20) & 0xFu; }
#define XB_SPIN(cond, bar) do { unsigned _sp = 0; while (cond) { __builtin_amdgcn_s_sleep(1); \
    if ((++_sp & 255u) == 0u) { if (xb_ld(&(bar)[XB_TMO])) break; if (_sp > XB_SPIN_CAP) { atomicAdd(&(bar)[XB_TMO], 1u); break; } } } } while (0)

struct XcdBarrier {
    unsigned* bar; unsigned x;
    volatile LAS unsigned* st;
};

__device__ __forceinline__ XcdBarrier xcd_barrier_post(unsigned* bar, volatile LAS unsigned* st) {
    XcdBarrier b; b.bar = bar; b.x = xb_xcc_id(); b.st = st;
    if (threadIdx.x == 0) (void)xb_add(&bar[XB_XCNT(b.x)], 1u);
    return b;
}
__device__ __forceinline__ void xcd_barrier_complete(unsigned* bar, unsigned x, unsigned& nloc, unsigned& nx) {
    const unsigned G = gridDim.x * gridDim.y * gridDim.z;
    unsigned sum, cnt, mine, sp = 0u;
    for (;;) {
        sum = 0u; cnt = 0u; mine = 0u;
#pragma unroll
        for (unsigned j = 0; j < 16; ++j) { const unsigned c = xb_ld(&bar[XB_XCNT(j)]); sum += c; cnt += (c > 0u) ? 1u : 0u; mine = (j == x) ? c : mine; }
        if (sum == G) break;
        __builtin_amdgcn_s_sleep(1);
        if ((++sp & 255u) == 0u) { if (xb_ld(&bar[XB_TMO])) break; if (sp > XB_SPIN_CAP) { atomicAdd(&bar[XB_TMO], 1u); break; } }
    }
    nloc = mine > 0u ? mine : 1u; nx = cnt > 0u ? cnt : 1u;
}

__device__ __forceinline__ void xcd_barrier(const XcdBarrier& b) {
    asm volatile("s_waitcnt vmcnt(0)" ::: "memory");
    __syncthreads();
    if (threadIdx.x == 0) {
        unsigned* bar = b.bar;
        __builtin_amdgcn_s_waitcnt(0);
        unsigned nloc = b.st[0], nx = b.st[1];
        if (nloc == 0u) { xcd_barrier_complete(bar, b.x, nloc, nx); b.st[0] = nloc; b.st[1] = nx; }
        const unsigned old = xb_add(&bar[XB_XSUB(b.x)], 1u);
        const unsigned gen = old / nloc;
        if (old + 1u == (gen + 1u) * nloc) {
            __builtin_amdgcn_fence(__ATOMIC_RELEASE, "agent");
            asm volatile("s_waitcnt vmcnt(0)" ::: "memory");
            const unsigned og = xb_add(&bar[XB_TOP], 1u);
            const unsigned tg = og / nx;
            if (og + 1u == (tg + 1u) * nx) xb_add(&bar[XB_TOPGEN], 1u);
            else XB_SPIN(xb_ld(&bar[XB_TOPGEN]) == tg, bar);
            __builtin_amdgcn_fence(__ATOMIC_ACQUIRE, "agent");
            xb_add(&bar[XB_XGEN(b.x)], 1u);
            asm volatile("s_waitcnt vmcnt(0)" ::: "memory");
        } else {
            XB_SPIN(xb_ld(&bar[XB_XGEN(b.x)]) == gen, bar);
            __builtin_amdgcn_fence(__ATOMIC_ACQUIRE, "agent");
            asm volatile("s_waitcnt vmcnt(0)" ::: "memory");
        }
    }
    __syncthreads();
}

__device__ __forceinline__ float rs_from_partials(const f32x4 (&q)[4]) {
    const f32x4 t = (q[0] + q[1]) + (q[2] + q[3]); const float s = (t[0] + t[1]) + (t[2] + t[3]);
    return rsqrtf(s * (1.0f / DM) + EPS);
}
struct EpiSwiGLU {
    static constexpr bool PERM = true, AFTER_DRAIN = false;
    bf16_t* ACT; const float* ss;
    __device__ __forceinline__ void operator()(const f32x4 (&acc)[2][2][4][2], const pg8::Unit& u, int wr, int wc, int fr, int fq) const {
        const int row0 = u.pm * 256 + wr * 64 + fr, col0 = u.pn * 128 + wc * 32 + 8 * fq;
        f32x4 pq[2][4]; float rsv[2][4];
#pragma unroll
        for (int ai = 0; ai < 2; ++ai)
#pragma unroll
            for (int m = 0; m < 4; ++m) pq[ai][m] = *(const f32x4*)(ss + (size_t)(row0 + ai * 128 + m * 16) * 16 + 4 * fq);
        SCHED_FENCE();
#pragma unroll
        for (int ai = 0; ai < 2; ++ai)
#pragma unroll
            for (int m = 0; m < 4; ++m) { const f32x4 t = pq[ai][m]; float s = (t[0] + t[1]) + (t[2] + t[3]); s = x1632_sum(s); rsv[ai][m] = rsqrtf(s * (1.0f / DM) + EPS); }
#pragma unroll
        for (int ai = 0; ai < 2; ++ai) {
#pragma unroll
            for (int m = 0; m < 4; ++m) {
                const int row = row0 + ai * 128 + m * 16;
                const float rs = rsv[ai][m];
                typedef float f32x2e __attribute__((ext_vector_type(2)));
                const float kk = -rs * LOG2E, rs2 = rs * rs;
                f32x2e o2[4];
#pragma unroll
                for (int n = 0; n < 2; ++n)
#pragma unroll
                    for (int e = 0; e < 2; ++e) { const f32x2e a = {acc[ai][0][m][n][2 * e], acc[ai][0][m][n][2 * e + 1]}, bq = {acc[ai][1][m][n][2 * e], acc[ai][1][m][n][2 * e + 1]};
                        f32x2e ex = a * kk; ex.x = __builtin_amdgcn_exp2f(ex.x); ex.y = __builtin_amdgcn_exp2f(ex.y);
                        f32x2e d = ex + 1.0f; d.x = __builtin_amdgcn_rcpf(d.x); d.y = __builtin_amdgcn_rcpf(d.y);
                        o2[2 * n + e] = ((a * bq) * d) * rs2; }
                u32x4 w; w.x = pkbf(o2[0].x, o2[0].y); w.y = pkbf(o2[1].x, o2[1].y); w.z = pkbf(o2[2].x, o2[2].y); w.w = pkbf(o2[3].x, o2[3].y);
                *(u32x4*)(ACT + blk(row, col0, MTOK)) = w;
            }
            SCHED_FENCE();
        }
    }
};
struct EpiResid {
    static constexpr bool PERM = true, AFTER_DRAIN = false;
    const float* base32; float* out32; bf16_t* xb; float* ssn; float alpha;
    __device__ __forceinline__ void operator()(const f32x4 (&acc)[2][2][4][2], const pg8::Unit& u, int wr, int wc, int fr, int fq) const {
        const int row0 = u.pm * 256 + wr * 64 + fr, col0 = u.pn * 256 + wc * 32 + 8 * fq;
        if (base32) {
#pragma unroll
            for (int ai = 0; ai < 2; ++ai) {
                f32x4 bv[4][2][2];
#pragma unroll
                for (int m = 0; m < 4; ++m)
#pragma unroll
                    for (int bj = 0; bj < 2; ++bj) { const size_t off = (size_t)(row0 + ai * 128 + m * 16) * DM + col0 + bj * 128; bv[m][bj][0] = *(const f32x4*)(base32 + off); bv[m][bj][1] = *(const f32x4*)(base32 + off + 4); }
                SCHED_FENCE();
#pragma unroll
                for (int m = 0; m < 4; ++m) {
                    const int row = row0 + ai * 128 + m * 16; float sq = 0.f;
#pragma unroll
                    for (int bj = 0; bj < 2; ++bj) {
                        const f32x4 v0 = bv[m][bj][0] + acc[ai][bj][m][0] * alpha, v1 = bv[m][bj][1] + acc[ai][bj][m][1] * alpha;
                        u32x4 w; w.x = pkbf(v0[0], v0[1]); w.y = pkbf(v0[2], v0[3]); w.z = pkbf(v1[0], v1[1]); w.w = pkbf(v1[2], v1[3]); *(u32x4*)(xb + blk(row, col0 + bj * 128, MTOK)) = w;
                        sq += (v0[0] * v0[0] + v0[1] * v0[1]) + (v0[2] * v0[2] + v0[3] * v0[3]) + (v1[0] * v1[0] + v1[1] * v1[1]) + (v1[2] * v1[2] + v1[3] * v1[3]);
                    }
                    sq = x1632_sum(sq); if (fq == 0) ssn[(size_t)row * 16 + u.pn * 4 + wc] = sq;
                }
                SCHED_FENCE();
            }
        } else {
#pragma unroll
            for (int ai = 0; ai < 2; ++ai) {
                u32x4 bw[4][2];
#pragma unroll
                for (int m = 0; m < 4; ++m)
#pragma unroll
                    for (int bj = 0; bj < 2; ++bj) bw[m][bj] = *(const u32x4*)(xb + blk(row0 + ai * 128 + m * 16, col0 + bj * 128, MTOK));
                SCHED_FENCE();
#pragma unroll
                for (int m = 0; m < 4; ++m) {
                    const int row = row0 + ai * 128 + m * 16; float sq = 0.f;
#pragma unroll
                    for (int bj = 0; bj < 2; ++bj) {
                        const u32x4 b = bw[m][bj];
                        const f32x4 b0 = {bflo(b.x), bfhi(b.x), bflo(b.y), bfhi(b.y)}, b1 = {bflo(b.z), bfhi(b.z), bflo(b.w), bfhi(b.w)};
                        const f32x4 v0 = b0 + acc[ai][bj][m][0] * alpha, v1 = b1 + acc[ai][bj][m][1] * alpha;
                        if (out32) { const size_t off = (size_t)row * DM + col0 + bj * 128; *(f32x4*)(out32 + off) = v0; *(f32x4*)(out32 + off + 4) = v1; }
                        else { u32x4 w; w.x = pkbf(v0[0], v0[1]); w.y = pkbf(v0[2], v0[3]); w.z = pkbf(v1[0], v1[1]); w.w = pkbf(v1[2], v1[3]); *(u32x4*)(xb + blk(row, col0 + bj * 128, MTOK)) = w;
                            sq += (v0[0] * v0[0] + v0[1] * v0[1]) + (v0[2] * v0[2] + v0[3] * v0[3]) + (v1[0] * v1[0] + v1[1] * v1[1]) + (v1[2] * v1[2] + v1[3] * v1[3]); }
                    }
                    if (!out32) { sq = x1632_sum(sq); if (fq == 0) ssn[(size_t)row * 16 + u.pn * 4 + wc] = sq; }
                }
                SCHED_FENCE();
            }
        }
    }
};
struct EpiNull {
    static constexpr bool PERM = true, AFTER_DRAIN = false;
    float* dump;
    __device__ __forceinline__ void operator()(const f32x4 (&acc)[2][2][4][2], const pg8::Unit& u, int wr, int wc, int fr, int fq) const {
        f32x4 s = {0.f, 0.f, 0.f, 0.f};
#pragma unroll
        for (int ai = 0; ai < 2; ++ai)
#pragma unroll
            for (int bj = 0; bj < 2; ++bj)
#pragma unroll
                for (int m = 0; m < 4; ++m) s += acc[ai][bj][m][0] + acc[ai][bj][m][1];
        *(f32x4*)(dump + ((size_t)blockIdx.x * 512 + threadIdx.x) * 4) = s;
    }
};
struct EpiProj {
    static constexpr bool PERM = true, AFTER_DRAIN = false;
    bf16_t* P; const float* ss; float* FFB;
    __device__ __forceinline__ void operator()(const f32x4 (&acc)[2][2][4][2], const pg8::Unit& u, int wr, int wc, int fr, int fq) const {
        const int row0 = u.pm * 256 + wr * 64 + fr, col0 = u.pn * 256 + wc * 32 + 8 * fq;
        f32x4 pq[2][4]; float rsv[2][4];
#pragma unroll
        for (int ai = 0; ai < 2; ++ai)
#pragma unroll
            for (int m = 0; m < 4; ++m) pq[ai][m] = *(const f32x4*)(ss + (size_t)(row0 + ai * 128 + m * 16) * 16 + 4 * fq);
        SCHED_FENCE();
#pragma unroll
        for (int ai = 0; ai < 2; ++ai)
#pragma unroll
            for (int m = 0; m < 4; ++m) { const f32x4 t = pq[ai][m]; float s = (t[0] + t[1]) + (t[2] + t[3]); s = x1632_sum(s); rsv[ai][m] = rsqrtf(s * (1.0f / DM) + EPS); }
#pragma unroll
        for (int ai = 0; ai < 2; ++ai) {
#pragma unroll
            for (int m = 0; m < 4; ++m) {
                const int row = row0 + ai * 128 + m * 16;
                const float rs = rsv[ai][m];
#pragma unroll
                for (int bj = 0; bj < 2; ++bj) {
                    const f32x4 v0 = acc[ai][bj][m][0] * rs, v1 = acc[ai][bj][m][1] * rs;
                    u32x4 w; w.x = pkbf(v0[0], v0[1]); w.y = pkbf(v0[2], v0[3]); w.z = pkbf(v1[0], v1[1]); w.w = pkbf(v1[2], v1[3]);
                    *(u32x4*)(P + (size_t)row * NINP + col0 + bj * 128) = w;
                    if (bj == 1 && u.pn == 8 && wc == 0 && fq == 0) *(f32x4*)(FFB + (size_t)row * 4) = v0;
                }
            }
            SCHED_FENCE();
        }
    }
};

__device__ __forceinline__ float rope_inv(int i) {
    const float t[8] = {1.0f, 0.1939227432012558f, 0.03760603070259094f, 0.007292664609849453f, 0.0014142135623842478f, 0.00027424818836152554f, 5.318296098266728e-05f, 1.0313386155758053e-05f};
    float r = t[0];
#pragma unroll
    for (int k = 1; k < 8; ++k) r = (i == k) ? t[k] : r;
    return r;
}

__device__ __forceinline__ void tr_item(const float* ja, const float* jb_, const float* gain, bf16_t* dst, const int N, const int mode, const int K, const int Nd, const bool blocked, LAS float* scr, int item, int lane) {
    const int nblk = Nd >> 5, kb = item / nblk, nb = item - kb * nblk, k0 = 64 * kb, n0 = 32 * nb, kr = lane >> 3, c4 = lane & 7;
    const float* cp; int stride;
    { const int n = n0 + 4 * c4;
      if (mode == 0) { cp = ja + n; stride = N; }
      else if (mode == 1) { const int pn = n >> 8, wi = n & 255; cp = ((wi < 128) ? ja : jb_) + pn * 128 + (wi & 127); stride = DFF; }
      else { int s; if (n < 768) s = n; else if (n < 1920) s = n + 4; else if (n < 2176) s = n + 16; else if (n < 2180) s = 768 + (n - 2176); else if (n < 2192) s = 1924 + (n - 2180); else s = -1;
             cp = (s >= 0) ? ja + s : nullptr; stride = NIN; } }
    f32x4 v[8];
#pragma unroll
    for (int i = 0; i < 8; ++i) { const int k = k0 + 8 * i + kr; v[i] = cp ? *(const f32x4*)(cp + (size_t)k * stride) : (f32x4){0.f, 0.f, 0.f, 0.f}; if (gain) v[i] = v[i] * gain[k]; }
#pragma unroll
    for (int i = 0; i < 8; ++i) { LAS float* w = scr + (8 * i + kr) * 33 + 4 * c4; w[0] = v[i][0]; w[1] = v[i][1]; w[2] = v[i][2]; w[3] = v[i][3]; }
    LDS_WAIT();
    const int c = lane & 7;
#pragma unroll
    for (int j = 0; j < 4; ++j) { const int n = (lane >> 3) + 8 * j; const LAS float* s = scr + (8 * c) * 33 + n;
        u32x4 o; o.x = pkbf(s[0], s[33]); o.y = pkbf(s[66], s[99]); o.z = pkbf(s[132], s[165]); o.w = pkbf(s[198], s[231]);
        *(u32x4*)(dst + (blocked ? ((size_t)kb * Nd + n0 + n) * 64 + 8 * c : (size_t)(n0 + n) * K + k0 + 8 * c)) = o; }
    LDS_WAIT();
}
constexpr int PJ_TOT = 10648;
__device__ __forceinline__ void prologue(const Args& A, LAS unsigned char* lds) {
    const int tid = ltid(), lane = tid & 63, wave = tid >> 6;
    const int gw = blockIdx.x * NWAVE + wave, NGW = gridDim.x * NWAVE;
    LAS float* scr = (LAS float*)(lds + wave * 16384);
    for (int it = gw; it < DEPTH * PJ_TOT; it += NGW) {
        const int l = (it >= PJ_TOT) ? 1 : 0; int r = it - l * PJ_TOT;
        unsigned char* wl = A.ws + WS_W + (size_t)l * WL_STRIDE;
        const float* ja; const float* jb_ = nullptr; const float* gain = nullptr; unsigned char* dst; int N, mode = 0, K, Nd; const bool blocked = (r < 10112);
        if (r < 2816) { ja = A.in[2] + (size_t)l * DM * DFF; jb_ = A.in[3] + (size_t)l * DM * DFF; gain = A.in[1] + l * DM; dst = wl + WL_W13A; N = DFF; mode = 1; K = DM; Nd = 2 * DFF; }
        else if (r < 4224) { r -= 2816; ja = A.in[4] + (size_t)l * DFF * DM; dst = wl + WL_W2A; N = DM; K = DFF; Nd = DM; }
        else if (r < 5376) { r -= 4224; ja = A.in[6] + (size_t)l * DM * NIN; gain = A.in[5] + l * DM; dst = wl + WL_WIN; N = NIN; mode = 2; K = DM; Nd = NINP; }
        else if (r < 5888) { r -= 5376; ja = A.in[7] + (size_t)l * DM * DM; dst = wl + WL_WOUT; N = DM; K = DM; Nd = DM; }
        else if (r < 8704) { r -= 5888; ja = A.in[28] + (size_t)l * DM * DFF; jb_ = A.in[29] + (size_t)l * DM * DFF; gain = A.in[27] + l * DM; dst = wl + WL_W13B; N = DFF; mode = 1; K = DM; Nd = 2 * DFF; }
        else if (r < 10112) { r -= 8704; ja = A.in[30] + (size_t)l * DFF * DM; dst = wl + WL_W2B; N = DM; K = DFF; Nd = DM; }
        else if (r < 10368) { r -= 10112; ja = A.in[19] + (size_t)l * 2048 * 256; dst = wl + WL_CK1; N = 256; K = 2048; Nd = 256; }
        else if (r < 10624) { r -= 10368; ja = A.in[22] + (size_t)l * 2048 * 256; dst = wl + WL_CV1; N = 256; K = 2048; Nd = 256; }
        else if (r < 10632) { r -= 10624; ja = A.in[20] + (size_t)l * 256 * 64; dst = wl + WL_CK2; N = 64; K = 256; Nd = 64; }
        else if (r < 10640) { r -= 10632; ja = A.in[23] + (size_t)l * 256 * 64; dst = wl + WL_CV2; N = 64; K = 256; Nd = 64; }
        else { r -= 10640; const int g = r >> 1; r &= 1; ja = A.in[25] + (size_t)l * 4 * 4096 + g * 4096; dst = wl + WL_PWT + g * 8192; N = 64; K = 64; Nd = 64; }
        tr_item(ja, jb_, gain, (bf16_t*)dst, N, mode, K, Nd, blocked, scr, r, lane);
    }
    { float* rt = (float*)(A.ws + WS_ROPE);
      for (int i = blockIdx.x * NTHR + tid; i < SEQ * 8; i += gridDim.x * NTHR) { const int t = i >> 3, k = i & 7; float sn, cs; sincosf((float)t * rope_inv(k), &sn, &cs); rt[t * 16 + k] = cs; rt[t * 16 + 8 + k] = sn; } }
    { const int gt = blockIdx.x * NTHR + tid, NGT = gridDim.x * NTHR;
      for (int i = gt; i < DEPTH * 4 * 128 * 128; i += NGT) { const int l = i >> 16, r = i & 65535, t = (r >> 7) & 127, s = r & 127;
          const float v = (s <= t) ? A.in[12][i] : 0.f; ((bf16_t*)(A.ws + WS_W + (size_t)l * WL_STRIDE + WL_GWS))[r] = (bf16_t)(pkbf(v, 0.f) & 0xffffu); }
    }
    { const float* x = A.in[0]; bf16_t* xb = (bf16_t*)(A.ws + WS_XB); float* ss = (float*)(A.ws + WS_SSP);
      for (int m = gw; m < MTOK; m += NGW) {
          const f32x4* xr = (const f32x4*)(x + (size_t)m * DM) + lane; f32x4 v[4]; float s = 0.f;
#pragma unroll
          for (int j = 0; j < 4; ++j) { v[j] = xr[64 * j]; s += (v[j][0] * v[j][0] + v[j][1] * v[j][1]) + (v[j][2] * v[j][2] + v[j][3] * v[j][3]); }
          s = wave_sum(s);
#pragma unroll
          for (int j = 0; j < 4; ++j) { u32x2 w; w.x = pkbf(v[j][0], v[j][1]); w.y = pkbf(v[j][2], v[j][3]); *(u32x2*)(xb + blk(m, 4 * lane + 256 * j, MTOK)) = w; }
          if (lane < 16) ss[(size_t)m * 16 + lane] = (lane == 0) ? s : 0.f;
      } }
}

struct LP {
    const bf16_t* P; const float* FFB; const float* ROPE; bf16_t *FQ, *FK, *FVT, *NQ, *NKS, *NVST, *NKW, *NVWT, *KCMP, *VCMPT, *O; float *FC, *NG;
    const float *fqn, *fkn, *nqn, *nkcn, *nksn, *nkwn, *fbias, *gbias, *gvn, *gbs, *posk, *posv, *pscale;
    const bf16_t *GWS, *PWT, *CK1, *CV1, *CK2, *CV2;
};
__device__ __forceinline__ LP make_lp(const Args& A, int l) {
    LP p; unsigned char* ws = A.ws; unsigned char* wl = ws + WS_W + (size_t)l * WL_STRIDE;
    p.P = (const bf16_t*)(ws + WS_R1); p.FFB = (const float*)(ws + WS_FFB); p.ROPE = (const float*)(ws + WS_ROPE); p.FQ = (bf16_t*)(ws + WS_FQ); p.FK = (bf16_t*)(ws + WS_FK); p.FVT = (bf16_t*)(ws + WS_FVT); p.NQ = (bf16_t*)(ws + WS_NQ);
    p.NKS = (bf16_t*)(ws + WS_NKS); p.NVST = (bf16_t*)(ws + WS_NVST); p.NKW = (bf16_t*)(ws + WS_NKW); p.NVWT = (bf16_t*)(ws + WS_NVWT);
    p.KCMP = (bf16_t*)(ws + WS_KCMP); p.VCMPT = (bf16_t*)(ws + WS_VCMPT); p.O = (bf16_t*)(ws + WS_O); p.FC = (float*)(ws + WS_FC); p.NG = (float*)(ws + WS_NG);
    p.fqn = A.in[9] + l * 64; p.fkn = A.in[10] + l * 64; p.nqn = A.in[14] + l * 64; p.nkcn = A.in[15] + l * 64; p.nksn = A.in[16] + l * 64; p.nkwn = A.in[17] + l * 64;
    p.fbias = A.in[8] + l * 4; p.gbias = A.in[24] + l * 12; p.gvn = A.in[11] + l * 256; p.gbs = A.in[13] + l * 512; p.posk = A.in[18] + l * 2048; p.posv = A.in[21] + l * 2048; p.pscale = A.in[26] + l * 256;
    p.GWS = (const bf16_t*)(wl + WL_GWS); p.PWT = (const bf16_t*)(wl + WL_PWT); p.CK1 = (const bf16_t*)(wl + WL_CK1); p.CV1 = (const bf16_t*)(wl + WL_CV1); p.CK2 = (const bf16_t*)(wl + WL_CK2); p.CV2 = (const bf16_t*)(wl + WL_CV2);
    return p;
}
constexpr int TT_CS = 0, TT_T = 4096, TT_TP = 784  , TT_Z = TT_T + 64 * TT_TP, TT_ZP = 528, TT_PL = TT_Z + 79 * TT_ZP, TT_END = TT_PL + 64 * TT_ZP;
static_assert(TT_END <= LDS_BYTES, "prep tile LDS");
__device__ __forceinline__ void prep_tile(const LP& p, int b, int t0, LAS unsigned char* lds) {
    const int tid = ltid(), lane = tid & 63, wave = tid >> 6;
    const size_t mb = (size_t)b * SEQ + t0;
    __syncthreads();
    { u32x4 sz[5];
#pragma unroll
      for (int i = 0; i < 5; ++i) { const int c = tid + i * NTHR, r = c >> 5, ch = c & 31; const int t = t0 - 15 + r; sz[i] = (u32x4){0u, 0u, 0u, 0u};
          if (c < 79 * 32 && t >= 0) sz[i] = *(const u32x4*)(p.P + ((size_t)b * SEQ + t) * NINP + C_PZ + 8 * ch); }
      SCHED_FENCE();
#pragma unroll
      for (int i = 0; i < 5; ++i) { const int c = tid + i * NTHR, r = c >> 5, ch = c & 31; if (c < 79 * 32) *(LAS u32x4*)(lds + TT_Z + r * TT_ZP + 16 * ch) = sz[i]; } }
    __syncthreads();
    { const int tok = tid >> 3, sub = tid & 7; const int t = t0 + tok;
      u32x4 rawv[6];
#pragma unroll
      for (int v = 0; v < 6; ++v) { const int col = (v < 4) ? (C_FK + 64 * v) : (v == 4 ? C_NKS : C_NKW);
          rawv[v] = *(const u32x4*)(p.P + (mb + tok) * NINP + col + 8 * sub); }
      f32x4 gnv[3][2];
#pragma unroll
      for (int k = 0; k < 3; ++k) { const float* gp = (k == 0) ? p.fkn : (k == 1 ? p.nksn : p.nkwn); gnv[k][0] = *(const f32x4*)(gp + 8 * sub); gnv[k][1] = *(const f32x4*)(gp + 8 * sub + 4); }
      const float* rrow = p.ROPE + (size_t)t * 16;
      const f32x4 rc0 = *(const f32x4*)(rrow), rc1 = *(const f32x4*)(rrow + 4), rs0 = *(const f32x4*)(rrow + 8), rs1 = *(const f32x4*)(rrow + 12);
      SCHED_FENCE();
      float csn[8], ssn[8];
#pragma unroll
      for (int e = 0; e < 8; ++e) { csn[e] = (e < 4) ? rc0[e] : rc1[e - 4]; ssn[e] = (e < 4) ? rs0[e] : rs1[e - 4]; }
#pragma unroll
      for (int v = 0; v < 6; ++v) {
          bf16_t* dst; const bool rope = (v >= 4); const int gk = (v < 4) ? 0 : (v == 4 ? 1 : 2);
          if (v < 4) dst = p.FK + (((size_t)b * 4 + v) * SEQ + t) * 64;
          else if (v == 4) dst = p.NKS + ((size_t)b * SEQ + t) * 64;
          else dst = p.NKW + ((size_t)b * SEQ + t) * 64;
          const u32x4 raw = rawv[v];
          float x[8] = {bflo(raw.x), bfhi(raw.x), bflo(raw.y), bfhi(raw.y), bflo(raw.z), bfhi(raw.z), bflo(raw.w), bfhi(raw.w)};
          float sq = 0.f;
#pragma unroll
          for (int e = 0; e < 8; ++e) sq += x[e] * x[e];
          sq += __shfl_xor(sq, 1); sq += __shfl_xor(sq, 2); sq += __shfl_xor(sq, 4);
          const float rs = rsqrtf(sq * (1.0f / 64.0f) + EPS);
          const f32x4 g0 = gnv[gk][0], g1 = gnv[gk][1];
#pragma unroll
          for (int e = 0; e < 4; ++e) { x[e] = x[e] * rs * g0[e]; x[4 + e] = x[4 + e] * rs * g1[e]; }
          if (rope) {
#pragma unroll
              for (int e = 0; e < 8; ++e) { const float other = __shfl_xor(x[e], 1);
                  const float r0 = x[e] * csn[e] - other * ssn[e], r1 = x[e] * csn[e] + other * ssn[e];
                  x[e] = (sub == 0) ? r0 : ((sub == 1) ? r1 : x[e]); }
          }
          u32x4 w; w.x = pkbf(x[0], x[1]); w.y = pkbf(x[2], x[3]); w.z = pkbf(x[4], x[5]); w.w = pkbf(x[6], x[7]);
          *(u32x4*)(dst + 8 * sub) = w;
      } }
    for (int c = tid; c < 64 * 12; c += NTHR) { const int tok = c / 12, k = c - tok * 12;
        const float v = bflo((unsigned)p.P[(mb + tok) * NINP + C_NG + k]) + p.gbias[k]; p.NG[(mb + tok) * 12 + k] = 1.f / (1.f + __expf(-v)); }
    { const int cp = tid & 127, seg = tid >> 7, g = cp >> 5, win = 2 << g;
      const LAS unsigned* z = (const LAS unsigned*)(lds + TT_Z) + cp;
      LAS unsigned* pl = (LAS unsigned*)(lds + TT_PL) + cp;
      const int tk0 = 16 * seg; float s0 = 0.f, s1 = 0.f;
      for (int k = 1; k < win; ++k) { const int t = t0 + tk0 - k; if (t >= 0) { const unsigned w = z[(15 + tk0 - k) * (TT_ZP / 4)]; s0 += bflo(w); s1 += bfhi(w); } }
#pragma unroll 4
      for (int tk = tk0; tk < tk0 + 16; ++tk) { const int t = t0 + tk; const unsigned w = z[(15 + tk) * (TT_ZP / 4)]; const float z0 = bflo(w), z1 = bfhi(w); s0 += z0; s1 += z1;
          const int cnt = (t + 1 < win) ? (t + 1) : win; const float inv = 1.0f / (float)cnt;
          pl[tk * (TT_ZP / 4)] = pkbf(s0 * inv - z0, s1 * inv - z1);
          if (t - win + 1 >= 0) { const unsigned wo = z[(15 + tk - win + 1) * (TT_ZP / 4)]; s0 -= bflo(wo); s1 -= bfhi(wo); } } }
    __syncthreads();
    { const int g = wave >> 1, mt0 = 2 * (wave & 1), l15 = lane & 15, l4 = lane >> 4;
      bf16x8 wa[4][2]; f32x4 scv[4];
#pragma unroll
      for (int et = 0; et < 4; ++et) { scv[et] = *(const f32x4*)(p.pscale + g * 64 + 16 * et + 4 * l4);
#pragma unroll
          for (int ks = 0; ks < 2; ++ks) wa[et][ks] = *(const bf16x8*)(p.PWT + g * 4096 + (16 * et + l15) * 64 + 32 * ks + 8 * l4); }
      SCHED_FENCE();
#pragma unroll
      for (int mi = 0; mi < 2; ++mi) { const int mt = mt0 + mi;
          bf16x8 bfr[2];
#pragma unroll
          for (int ks = 0; ks < 2; ++ks) bfr[ks] = *(const LAS bf16x8*)(lds + TT_PL + (16 * mt + l15) * TT_ZP + (g * 64 + 32 * ks + 8 * l4) * 2);
#pragma unroll
          for (int et = 0; et < 4; ++et) { f32x4 acc = {0.f, 0.f, 0.f, 0.f};
#pragma unroll
              for (int ks = 0; ks < 2; ++ks) acc = MFMA16(wa[et][ks], bfr[ks], acc);
              const int e0 = g * 64 + 16 * et + 4 * l4; const f32x4 sc = scv[et];
              u32x2 w; w.x = pkbf(acc[0] * sc[0], acc[1] * sc[1]); w.y = pkbf(acc[2] * sc[2], acc[3] * sc[3]);
              *(u32x2*)(p.O + blk(mb + 16 * mt + l15, 768 + e0, MTOK)) = w; } } }
}

__device__ __forceinline__ void prep_scan(const LP& p, int b, LAS unsigned char* lds) {
    const int tid = ltid(), lane = tid & 63, wave = tid >> 6;
    __syncthreads();
    float lf[4][4], tot[4] = {0.f, 0.f, 0.f, 0.f};
#pragma unroll
    for (int k = 0; k < 4; ++k) { const f32x4 fr4 = *(const f32x4*)(p.FFB + ((size_t)b * SEQ + 4 * tid + k) * 4);
        const float f[4] = {fr4[0], fr4[1], fr4[2], fr4[3]};
#pragma unroll
        for (int h = 0; h < 4; ++h) { const float x = f[h] + p.fbias[h]; const float v = -(fmaxf(-x, 0.f) + log1pf(expf(-fabsf(x)))); tot[h] += v; lf[k][h] = tot[h]; } }
    float pre[4];
#pragma unroll
    for (int h = 0; h < 4; ++h) { float v = tot[h];
#pragma unroll
        for (int o = 1; o < 64; o <<= 1) { const float u = __shfl_up(v, o); if (lane >= o) v += u; }
        pre[h] = v - tot[h];
        if (lane == 63) ((LAS float*)lds)[wave * 4 + h] = v; }
    __syncthreads();
#pragma unroll
    for (int h = 0; h < 4; ++h) { float base = 0.f; for (int w = 0; w < wave; ++w) base += ((const LAS float*)lds)[w * 4 + h];
#pragma unroll
        for (int k = 0; k < 4; ++k) p.FC[((size_t)b * 4 + h) * SEQ + 4 * tid + k] = (base + pre[h] + lf[k][h]) * LOG2E; }
}

constexpr int GM_VP = 272;
__device__ __forceinline__ void prep_gmlp(const LP& p, int b, int c, LAS unsigned char* lds) {
    const int tid = ltid(), lane = tid & 63, wave = tid >> 6;
    const size_t tb = (size_t)b * SEQ + 128 * c;
    __syncthreads();
    { const int tok = tid >> 2, g = tid & 3; float x[64]; float sq = 0.f;
#pragma unroll
      for (int k = 0; k < 8; ++k) { const u32x4 raw = *(const u32x4*)(p.P + (tb + tok) * NINP + C_GV + 64 * g + 8 * k);
          const float f[8] = {bflo(raw.x), bfhi(raw.x), bflo(raw.y), bfhi(raw.y), bflo(raw.z), bfhi(raw.z), bflo(raw.w), bfhi(raw.w)};
#pragma unroll
          for (int e = 0; e < 8; ++e) { const float v = gelu_t(f[e]); x[8 * k + e] = v; sq += v * v; } }
      const float rs = rsqrtf(sq * (1.0f / 64.0f) + EPS);
#pragma unroll
      for (int d = 0; d < 64; ++d) { const float v = x[d] * rs * p.gvn[64 * g + d]; ((LAS bf16_t*)(lds + (64 * g + d) * GM_VP))[tok] = (bf16_t)(pkbf(v, 0.f) & 0xffffu); } }
    __syncthreads();
    { const int g = wave >> 1, l15 = lane & 15, l4 = lane >> 4;
#pragma unroll 2
      for (int ti = 0; ti < 4; ++ti) { const int tt = 4 * (wave & 1) + ti; const int t = 16 * tt + l15;
          f32x4 acc[4];
#pragma unroll
          for (int dt = 0; dt < 4; ++dt) acc[dt] = (f32x4){0.f, 0.f, 0.f, 0.f};
          bf16x8 bwv[4];
#pragma unroll
          for (int ks = 0; ks < 4; ++ks) bwv[ks] = *(const bf16x8*)(p.GWS + ((size_t)g * 128 + t) * 128 + 32 * ks + 8 * l4);
          u32x2 urv[4];
#pragma unroll
          for (int dt = 0; dt < 4; ++dt) urv[dt] = *(const u32x2*)(p.P + (tb + t) * NINP + C_GU + 64 * g + 16 * dt + 4 * l4);
          const float bs = p.gbs[g * 128 + t];
          SCHED_FENCE();
#pragma unroll
          for (int ks = 0; ks < 4; ++ks) { if (ks <= (tt >> 1)) {
#pragma unroll
              for (int dt = 0; dt < 4; ++dt) { const bf16x8 a = *(const LAS bf16x8*)(lds + (64 * g + 16 * dt + l15) * GM_VP + (32 * ks + 8 * l4) * 2); acc[dt] = MFMA16(a, bwv[ks], acc[dt]); } } }
#pragma unroll
          for (int dt = 0; dt < 4; ++dt) { const int d0 = 64 * g + 16 * dt + 4 * l4;
              const u32x2 ur = urv[dt];
              const float u0 = gelu_t(bflo(ur.x)), u1 = gelu_t(bfhi(ur.x)), u2 = gelu_t(bflo(ur.y)), u3 = gelu_t(bfhi(ur.y));
              u32x2 w; w.x = pkbf(u0 * (acc[dt][0] + bs), u1 * (acc[dt][1] + bs)); w.y = pkbf(u2 * (acc[dt][2] + bs), u3 * (acc[dt][3] + bs));
              *(u32x2*)(p.O + blk(tb + t, 256 + d0, MTOK)) = w; } } }
}

constexpr int CM_HP = 528;
__device__ __forceinline__ void prep_cmp(const LP& p, int which, int b, int ng, LAS unsigned char* lds) {
    const int tid = ltid(), lane = tid & 63, wave = tid >> 6, l15 = lane & 15, l4 = lane >> 4;
    const bf16_t* W1 = which ? p.CV1 : p.CK1; const bf16_t* W2 = which ? p.CV2 : p.CK2; const float* pos = which ? p.posv : p.posk; const int ccol = which ? C_NVC : C_NKC;
    __syncthreads();
    { int n0 = 32 * ng + l15, n1 = n0 + 16; if (n0 > 126) n0 = 126; if (n1 > 126) n1 = 126;
      const bf16_t* ar0 = p.P + ((size_t)b * SEQ + 16 * n0) * NINP + ccol; const bf16_t* ar1 = p.P + ((size_t)b * SEQ + 16 * n1) * NINP + ccol;
      f32x4 acc[2][2];
#pragma unroll
      for (int i = 0; i < 2; ++i)
#pragma unroll
          for (int k = 0; k < 2; ++k) acc[i][k] = (f32x4){0.f, 0.f, 0.f, 0.f};
      const bf16_t* w0 = W1 + (size_t)(32 * wave + l15) * 2048 + 8 * l4; const bf16_t* w1 = w0 + 16 * 2048;
#pragma unroll 1
      for (int kb = 0; kb < 16; ++kb) {
          u32x4 ra[2][4]; f32x4 pp[4][2]; bf16x8 bb[2][4];
#pragma unroll
          for (int q = 0; q < 4; ++q) { const int ks = 4 * kb + q, tt = ks >> 1, d0 = 32 * (ks & 1) + 8 * l4;
              ra[0][q] = *(const u32x4*)(ar0 + (size_t)tt * NINP + d0); ra[1][q] = *(const u32x4*)(ar1 + (size_t)tt * NINP + d0);
              pp[q][0] = *(const f32x4*)(pos + tt * 64 + d0); pp[q][1] = *(const f32x4*)(pos + tt * 64 + d0 + 4);
              bb[0][q] = *(const bf16x8*)(w0 + 32 * ks); bb[1][q] = *(const bf16x8*)(w1 + 32 * ks); }
          SCHED_FENCE();
#pragma unroll
          for (int q = 0; q < 4; ++q)
#pragma unroll
              for (int i = 0; i < 2; ++i) { const u32x4 raw = ra[i][q]; const f32x4 p0 = pp[q][0], p1 = pp[q][1];
                  u32x4 aw; aw.x = pkbf(bflo(raw.x) + p0[0], bfhi(raw.x) + p0[1]); aw.y = pkbf(bflo(raw.y) + p0[2], bfhi(raw.y) + p0[3]);
                  aw.z = pkbf(bflo(raw.z) + p1[0], bfhi(raw.z) + p1[1]); aw.w = pkbf(bflo(raw.w) + p1[2], bfhi(raw.w) + p1[3]);
                  const bf16x8 a = __builtin_bit_cast(bf16x8, aw);
                  acc[i][0] = MFMA16(a, bb[0][q], acc[i][0]); acc[i][1] = MFMA16(a, bb[1][q], acc[i][1]); }
          SCHED_FENCE();
      }
#pragma unroll
      for (int i = 0; i < 2; ++i)
#pragma unroll
          for (int e = 0; e < 4; ++e) { LAS bf16_t* hr = (LAS bf16_t*)(lds + (16 * i + 4 * l4 + e) * CM_HP);
              hr[32 * wave + l15] = (bf16_t)(pkbf(gelu_t(acc[i][0][e]), 0.f) & 0xffffu); hr[32 * wave + 16 + l15] = (bf16_t)(pkbf(gelu_t(acc[i][1][e]), 0.f) & 0xffffu); } }
    __syncthreads();
    LAS float* outl = (LAS float*)(lds + 32 * CM_HP);
    { const int mt = wave >> 2, ct = wave & 3; f32x4 acc = {0.f, 0.f, 0.f, 0.f}; bf16x8 bw[8];
#pragma unroll
      for (int ks = 0; ks < 8; ++ks) bw[ks] = *(const bf16x8*)(W2 + (size_t)(16 * ct + l15) * 256 + 32 * ks + 8 * l4);
      SCHED_FENCE();
#pragma unroll
      for (int ks = 0; ks < 8; ++ks) { const bf16x8 a = *(const LAS bf16x8*)(lds + (16 * mt + l15) * CM_HP + (32 * ks + 8 * l4) * 2); acc = MFMA16(a, bw[ks], acc); }
#pragma unroll
      for (int e = 0; e < 4; ++e) outl[(16 * mt + 4 * l4 + e) * 65 + 16 * ct + l15] = acc[e]; }
    __syncthreads();
    if (which == 0) {
        if (tid < 256) { const int row = tid >> 3, sub = tid & 7, n = 32 * ng + row; float x[8]; float sq = 0.f;
#pragma unroll
            for (int e = 0; e < 8; ++e) { x[e] = outl[row * 65 + 8 * sub + e]; sq += x[e] * x[e]; }
            sq += __shfl_xor(sq, 1); sq += __shfl_xor(sq, 2); sq += __shfl_xor(sq, 4);
            const float rs = rsqrtf(sq * (1.0f / 64.0f) + EPS);
#pragma unroll
            for (int e = 0; e < 8; ++e) x[e] = x[e] * rs * p.nkcn[8 * sub + e];
            const float* rrow = p.ROPE + (size_t)((n < 127) ? (16 * n + 31) : 0) * 16;
#pragma unroll
            for (int e = 0; e < 8; ++e) { const float other = __shfl_xor(x[e], 1); const float cs = rrow[e], sn = rrow[8 + e];
                const float r0 = x[e] * cs - other * sn, r1 = x[e] * cs + other * sn; x[e] = (sub == 0) ? r0 : ((sub == 1) ? r1 : x[e]); }
            u32x4 w; w.x = pkbf(x[0], x[1]); w.y = pkbf(x[2], x[3]); w.z = pkbf(x[4], x[5]); w.w = pkbf(x[6], x[7]);
            if (n >= 127) w = (u32x4){0u, 0u, 0u, 0u};
            *(u32x4*)(p.KCMP + ((size_t)b * 128 + n) * 64 + 8 * sub) = w; }
    } else {
        for (int c2 = tid; c2 < 2048; c2 += NTHR) { const int d = c2 >> 5, row = c2 & 31, n = 32 * ng + row;
            const float v = (n < 127) ? outl[row * 65 + d] : 0.f; p.VCMPT[((size_t)b * 64 + d) * 128 + n] = (bf16_t)(pkbf(v, 0.f) & 0xffffu); }
    }
}

constexpr int AT_KOFF = 0, AT_VOFF = 9216, AT_COFF = 18432, AT_BUF = 18688, AT_P = 144;
typedef short v4i16_t __attribute__((ext_vector_type(4)));
__device__ __forceinline__ s16x4 vtr(const LAS unsigned char* p) { return __builtin_bit_cast(s16x4, __builtin_amdgcn_ds_read_tr16_b64_v4i16((LAS v4i16_t*)p)); }
template <int MODE>
__device__ __forceinline__ void attn_tile(const LAS unsigned char* buf, const int j, const bf16x8 (&qf)[4], const int qpos, const unsigned selm, const int wq_lo, const int r32, const int h,
                                          float& m, float& lsum, f32x16 (&o)[2]) {
    const int key0 = 64 * j;
    bool active = key0 <= wq_lo + 31; if (MODE == 2) active = active && (key0 + 63 + 512 > wq_lo);
    const bool selok = (MODE != 1) || (((selm >> j) & 1u) != 0u);
    if (MODE == 1) active = active && (__builtin_amdgcn_ballot_w64(selok) != 0ull);
    if (!active) return;
    f32x16 s[2];
#pragma unroll
    for (int i = 0; i < 16; ++i) { s[0][i] = 0.f; s[1][i] = 0.f; }
    { bf16x8 ka[2][4];
#pragma unroll
      for (int st = 0; st < 4; ++st) { ka[0][st] = *(const LAS bf16x8*)(buf + AT_KOFF + r32 * AT_P + 32 * st + 16 * h); ka[1][st] = *(const LAS bf16x8*)(buf + AT_KOFF + (32 + r32) * AT_P + 32 * st + 16 * h); }
      __builtin_amdgcn_s_setprio(1);
#pragma unroll
      for (int st = 0; st < 4; ++st) { s[0] = MFMA32(ka[0][st], qf[st], s[0]); s[1] = MFMA32(ka[1][st], qf[st], s[1]); }
      __builtin_amdgcn_s_setprio(0); }
    const bool interior = (key0 + 63 <= wq_lo) && (MODE != 2 || (key0 + 512 > wq_lo + 31));
    float mx = -1e30f, csub;
    if (interior) {
#pragma unroll
        for (int kt = 0; kt < 2; ++kt)
#pragma unroll
            for (int g = 0; g < 4; ++g) {
                if (MODE == 0) { const f32x4 cv = *(const LAS f32x4*)(buf + AT_COFF + (32 * kt + 8 * g + 4 * h) * 4);
#pragma unroll
                    for (int e = 0; e < 4; ++e) s[kt][4 * g + e] -= cv[e]; }
                mx = fmaxf(mx, fmaxf(fmaxf(s[kt][4 * g], s[kt][4 * g + 1]), fmaxf(s[kt][4 * g + 2], s[kt][4 * g + 3]))); }
        mx = x32_max(mx);
        if (MODE == 1) mx = selok ? mx : -1e30f;
    } else {
#pragma unroll
        for (int kt = 0; kt < 2; ++kt)
#pragma unroll
            for (int g = 0; g < 4; ++g) {
                f32x4 cv = {0.f, 0.f, 0.f, 0.f}; if (MODE == 0) cv = *(const LAS f32x4*)(buf + AT_COFF + (32 * kt + 8 * g + 4 * h) * 4);
#pragma unroll
                for (int e = 0; e < 4; ++e) { const int key = key0 + 32 * kt + 8 * g + 4 * h + e; float v = s[kt][4 * g + e];
                    if (MODE == 0) v -= cv[e];
                    bool ok = (key <= qpos) && selok; if (MODE == 2) ok = ok && (key + 512 > qpos);
                    v = ok ? v : -3e38f; s[kt][4 * g + e] = v; mx = fmaxf(mx, v); } }
        mx = x32_max(mx);
        mx = fmaxf(mx, -1e30f);
    }
    const bool resc = __builtin_amdgcn_ballot_w64(mx > m + 8.0f) != 0ull;
    const float mn = resc ? fmaxf(m, mx) : m, alpha = resc ? __builtin_amdgcn_exp2f(m - mn) : 1.0f;
    csub = (mn > -1e29f) ? mn : 0.f;
    if (MODE == 1 && interior && !selok) csub = 3e38f;
    m = mn;
    s16x4 vlo[2][2][2], vhi[2][2][2];
#pragma unroll
    for (int kt = 0; kt < 2; ++kt)
#pragma unroll
        for (int s2 = 0; s2 < 2; ++s2)
#pragma unroll
            for (int dt = 0; dt < 2; ++dt) {
                const LAS unsigned char* vp = buf + AT_VOFF + (32 * kt + 16 * s2 + 4 * h + ((r32 & 15) >> 2)) * AT_P + (32 * dt + (r32 & 16) + 4 * (r32 & 3)) * 2;
                vlo[kt][s2][dt] = vtr(vp); vhi[kt][s2][dt] = vtr(vp + 8 * AT_P); }
    typedef float f32x2p __attribute__((ext_vector_type(2)));
    f32x2p ps2 = {0.f, 0.f}; const f32x2p cs2 = {csub, csub};
#pragma unroll
    for (int kt = 0; kt < 2; ++kt)
#pragma unroll
        for (int i = 0; i < 8; ++i) { f32x2p d = {s[kt][2 * i], s[kt][2 * i + 1]}; d = d - cs2; d.x = __builtin_amdgcn_exp2f(d.x); d.y = __builtin_amdgcn_exp2f(d.y); s[kt][2 * i] = d.x; s[kt][2 * i + 1] = d.y; ps2 += d; }
    lsum = lsum * alpha + (ps2.x + ps2.y);
    if (resc) {
#pragma unroll
        for (int i = 0; i < 16; ++i) { o[0][i] *= alpha; o[1][i] *= alpha; } }
#pragma unroll
    for (int kt = 0; kt < 2; ++kt)
#pragma unroll
        for (int s2 = 0; s2 < 2; ++s2) {
            u32x4 pw; pw.x = pkbf(s[kt][8 * s2 + 0], s[kt][8 * s2 + 1]); pw.y = pkbf(s[kt][8 * s2 + 2], s[kt][8 * s2 + 3]); pw.z = pkbf(s[kt][8 * s2 + 4], s[kt][8 * s2 + 5]); pw.w = pkbf(s[kt][8 * s2 + 6], s[kt][8 * s2 + 7]);
            const bf16x8 pb = __builtin_bit_cast(bf16x8, pw);
#pragma unroll
            for (int dt = 0; dt < 2; ++dt) { const bf16x8 a = __builtin_shufflevector(vlo[kt][s2][dt], vhi[kt][s2][dt], 0, 1, 2, 3, 4, 5, 6, 7); o[dt] = MFMA32(a, pb, o[dt]); } }
}
template <int MODE>
__device__ __forceinline__ void attn_run(LAS unsigned char* lds, const bf16_t* __restrict__ Kb, const bf16_t* __restrict__ Vb, const int vpitch, const float* __restrict__ Cb, unsigned tmask,
                                         const bf16x8 (&qf)[4], int qpos, float cq, unsigned selm, int wq_lo, f32x16 (&o)[2]) {
    const int tid = ltid(), lane = tid & 63, r32 = lane & 31, h = lane >> 5, lr = tid >> 3, lc = tid & 7;
#pragma unroll
    for (int i = 0; i < 16; ++i) { o[0][i] = 0.f; o[1][i] = 0.f; }
    float m = -1e30f, lsum = 0.f;
    __syncthreads();
    int ja = __builtin_ctz(tmask); tmask &= tmask - 1;
    int jb = -1; if (tmask) { jb = __builtin_ctz(tmask); tmask &= tmask - 1; }
    { const u32x4 kr = *(const u32x4*)(Kb + (size_t)(64 * ja + lr) * 64 + 8 * lc); const u32x4 vr = *(const u32x4*)(Vb + (size_t)(64 * ja + lr) * vpitch + 8 * lc);
      *(LAS u32x4*)(lds + AT_KOFF + lr * AT_P + 16 * lc) = kr; *(LAS u32x4*)(lds + AT_VOFF + lr * AT_P + 16 * lc) = vr;
      if (MODE == 0 && tid < 64) *(LAS float*)(lds + AT_COFF + 4 * tid) = Cb[64 * ja + tid];
      if (jb >= 0) { const u32x4 kr2 = *(const u32x4*)(Kb + (size_t)(64 * jb + lr) * 64 + 8 * lc); const u32x4 vr2 = *(const u32x4*)(Vb + (size_t)(64 * jb + lr) * vpitch + 8 * lc);
          *(LAS u32x4*)(lds + AT_BUF + AT_KOFF + lr * AT_P + 16 * lc) = kr2; *(LAS u32x4*)(lds + AT_BUF + AT_VOFF + lr * AT_P + 16 * lc) = vr2;
          if (MODE == 0 && tid < 64) *(LAS float*)(lds + AT_BUF + AT_COFF + 4 * tid) = Cb[64 * jb + tid]; } }
    __syncthreads();
    int cur = 0;
    for (;;) {
        const bool more = tmask != 0u; int na = 0, nb = -1; u32x4 kr = {0u, 0u, 0u, 0u}, vr = {0u, 0u, 0u, 0u}, kr2 = {0u, 0u, 0u, 0u}, vr2 = {0u, 0u, 0u, 0u}; float cr = 0.f, cr2 = 0.f;
        if (more) { na = __builtin_ctz(tmask); tmask &= tmask - 1; if (tmask) { nb = __builtin_ctz(tmask); tmask &= tmask - 1; }
            kr = *(const u32x4*)(Kb + (size_t)(64 * na + lr) * 64 + 8 * lc); vr = *(const u32x4*)(Vb + (size_t)(64 * na + lr) * vpitch + 8 * lc);
            if (MODE == 0 && tid < 64) cr = Cb[64 * na + tid];
            if (nb >= 0) { kr2 = *(const u32x4*)(Kb + (size_t)(64 * nb + lr) * 64 + 8 * lc); vr2 = *(const u32x4*)(Vb + (size_t)(64 * nb + lr) * vpitch + 8 * lc);
                if (MODE == 0 && tid < 64) cr2 = Cb[64 * nb + tid]; } }
        const LAS unsigned char* buf = lds + cur * (2 * AT_BUF);
        { attn_tile<MODE>(buf, ja, qf, qpos, selm, wq_lo, r32, h, m, lsum, o);
               if (jb >= 0) attn_tile<MODE>(buf + AT_BUF, jb, qf, qpos, selm, wq_lo, r32, h, m, lsum, o); }
        if (more) { LAS unsigned char* nbuf = lds + (cur ^ 1) * (2 * AT_BUF);
            *(LAS u32x4*)(nbuf + AT_KOFF + lr * AT_P + 16 * lc) = kr; *(LAS u32x4*)(nbuf + AT_VOFF + lr * AT_P + 16 * lc) = vr;
            if (MODE == 0 && tid < 64) *(LAS float*)(nbuf + AT_COFF + 4 * tid) = cr;
            if (nb >= 0) { *(LAS u32x4*)(nbuf + AT_BUF + AT_KOFF + lr * AT_P + 16 * lc) = kr2; *(LAS u32x4*)(nbuf + AT_BUF + AT_VOFF + lr * AT_P + 16 * lc) = vr2;
                if (MODE == 0 && tid < 64) *(LAS float*)(nbuf + AT_BUF + AT_COFF + 4 * tid) = cr2; } }
        __syncthreads();
        if (!more) break;
        ja = na; jb = nb; cur ^= 1;
    }
    const float lt = x32_sum(lsum); const float inv = (lt > 0.f) ? 1.0f / lt : 0.f;
#pragma unroll
    for (int i = 0; i < 16; ++i) { o[0][i] *= inv; o[1][i] *= inv; }
}
__device__ __forceinline__ void store_ot(bf16_t* orow, const f32x16 (&o)[2], int h) {
#pragma unroll
    for (int dt = 0; dt < 2; ++dt)
#pragma unroll
        for (int g = 0; g < 4; ++g) { u32x2 w; w.x = pkbf(o[dt][4 * g], o[dt][4 * g + 1]); w.y = pkbf(o[dt][4 * g + 2], o[dt][4 * g + 3]); *(u32x2*)(orow + 32 * dt + 8 * g + 4 * h) = w; }
}

template <bool ROPED>
__device__ __forceinline__ void load_q(const bf16_t* __restrict__ qrow, const float* __restrict__ gn, const float* __restrict__ ropet, const int h, bf16x8 (&qf)[4]) {
    u32x4 raw[4]; f32x4 g[4][2]; f32x4 cs[2], sn[2];
#pragma unroll
    for (int st = 0; st < 4; ++st) { raw[st] = *(const u32x4*)(qrow + 16 * st + 8 * h); g[st][0] = *(const f32x4*)(gn + 16 * st + 8 * h); g[st][1] = *(const f32x4*)(gn + 16 * st + 8 * h + 4); }
    if (ROPED) { cs[0] = *(const f32x4*)(ropet); cs[1] = *(const f32x4*)(ropet + 4); sn[0] = *(const f32x4*)(ropet + 8); sn[1] = *(const f32x4*)(ropet + 12); }
    float x[4][8]; float sq = 0.f;
#pragma unroll
    for (int st = 0; st < 4; ++st) { const u32x4 r = raw[st]; x[st][0] = bflo(r.x); x[st][1] = bfhi(r.x); x[st][2] = bflo(r.y); x[st][3] = bfhi(r.y); x[st][4] = bflo(r.z); x[st][5] = bfhi(r.z); x[st][6] = bflo(r.w); x[st][7] = bfhi(r.w);
#pragma unroll
        for (int e = 0; e < 8; ++e) sq += x[st][e] * x[st][e]; }
    sq = x32_sum(sq);
    const float rs = rsqrtf(sq * (1.0f / 64.0f) + EPS);
#pragma unroll
    for (int st = 0; st < 4; ++st)
#pragma unroll
        for (int e = 0; e < 4; ++e) { x[st][e] = x[st][e] * rs * g[st][0][e]; x[st][4 + e] = x[st][4 + e] * rs * g[st][1][e]; }
    if (ROPED) {
#pragma unroll
        for (int e = 0; e < 8; ++e) { auto t = __builtin_amdgcn_permlane32_swap(__float_as_uint(x[0][e]), __float_as_uint(x[0][e]), false, false);
            const float other = h ? __uint_as_float(t[0]) : __uint_as_float(t[1]);
            const float c1 = cs[e >> 2][e & 3], s1 = sn[e >> 2][e & 3];
            x[0][e] = h ? (x[0][e] * c1 + other * s1) : (x[0][e] * c1 - other * s1); } }
#pragma unroll
    for (int st = 0; st < 4; ++st) { u32x4 w; w.x = pkbf(x[st][0] * QSCALE, x[st][1] * QSCALE); w.y = pkbf(x[st][2] * QSCALE, x[st][3] * QSCALE); w.z = pkbf(x[st][4] * QSCALE, x[st][5] * QSCALE); w.w = pkbf(x[st][6] * QSCALE, x[st][7] * QSCALE);
        qf[st] = __builtin_bit_cast(bf16x8, w); }
}
__device__ __forceinline__ void fox_unit(const LP& p, int bh, int qb, LAS unsigned char* lds) {
    const int tid = ltid(), lane = tid & 63, wave = __builtin_amdgcn_readfirstlane(tid >> 6), r32 = lane & 31, h = lane >> 5;
    const int q0w = 256 * qb + 32 * wave, qpos = q0w + r32;
    bf16x8 qf[4];
    load_q<false>(p.P + ((size_t)(bh >> 2) * SEQ + qpos) * NINP + C_FQ + (bh & 3) * 64, p.fqn, nullptr, h, qf);
    const float cq = 0.f;
    const int nt = 4 * (qb + 1);
    const float c_first = p.FC[(size_t)bh * SEQ + 256 * qb];
    const float c_tile = (lane < nt) ? p.FC[(size_t)bh * SEQ + 64 * lane + 63] : 0.f;
    const unsigned tmask = (unsigned)__builtin_amdgcn_ballot_w64((lane < nt) && (c_first - c_tile >= -70.0f));
    f32x16 o[2];
    attn_run<0>(lds, p.FK + (size_t)bh * SEQ * 64, p.P + (size_t)(bh >> 2) * SEQ * NINP + C_FV + (bh & 3) * 64, NINP, p.FC + (size_t)bh * SEQ, tmask, qf, qpos, cq, 0u, q0w, o);
    const int b = bh >> 2, hh = bh & 3;
    int qq = qpos, hq = h; asm volatile("" : "+v"(qq), "+v"(hq));
    store_ot(p.O + blk((size_t)b * SEQ + qq, hh * 64, MTOK), o, hq);
}

constexpr int NS_IA = 0, NS_IB = NS_IA + 4 * 64 * 33 * 4, NS_IF = NS_IB + 4 * 64 * 33 * 4, NS_KC = NS_IF + 64 * 33 * 4, NS_KCP = 144, NS_VC = NS_KC + 128 * NS_KCP, NS_VCP = 272, NS_SEL = NS_VC + 64 * NS_VCP, NS_UM = NS_SEL + 256, NS_END = NS_UM + 16;
static_assert(4 * AT_BUF <= NS_KC, "attention buffers alias only the importance tables");
static_assert(NS_END <= LDS_BYTES, "nsa LDS");
__device__ __forceinline__ void nsa_unit(const LP& p, int b, int qblk, LAS unsigned char* lds) {
    const int tid = ltid(), lane = tid & 63, wave = __builtin_amdgcn_readfirstlane(tid >> 6), r32 = lane & 31, h = lane >> 5;
    const int hd = wave >> 1, qh = wave & 1, t0 = 64 * qblk, ql = 32 * qh + r32, qpos = t0 + ql, q0w = t0 + 32 * qh, cur = qblk;
    const size_t mrow = (size_t)b * SEQ + qpos;
    bf16x8 qf[4];
    load_q<true>(p.P + mrow * NINP + C_NQ + hd * 64, p.nqn, p.ROPE + (size_t)qpos * 16, h, qf);
    const float g0 = p.NG[mrow * 12 + hd * 3 + 0], g1 = p.NG[mrow * 12 + hd * 3 + 1], g2 = p.NG[mrow * 12 + hd * 3 + 2];
    { u32x4 kc0 = *(const u32x4*)(p.KCMP + ((size_t)b * 128 + (tid >> 3)) * 64 + 8 * (tid & 7)), kc1 = *(const u32x4*)(p.KCMP + ((size_t)b * 128 + 64 + (tid >> 3)) * 64 + 8 * (tid & 7));
      u32x4 vc0 = *(const u32x4*)(p.VCMPT + ((size_t)b * 64 + (tid >> 4)) * 128 + 8 * (tid & 15)), vc1 = *(const u32x4*)(p.VCMPT + ((size_t)b * 64 + 32 + (tid >> 4)) * 128 + 8 * (tid & 15));
      SCHED_FENCE();
      __syncthreads();
      *(LAS u32x4*)(lds + NS_KC + (tid >> 3) * NS_KCP + 16 * (tid & 7)) = kc0; *(LAS u32x4*)(lds + NS_KC + (64 + (tid >> 3)) * NS_KCP + 16 * (tid & 7)) = kc1;
      *(LAS u32x4*)(lds + NS_VC + (tid >> 4) * NS_VCP + 16 * (tid & 15)) = vc0; *(LAS u32x4*)(lds + NS_VC + (32 + (tid >> 4)) * NS_VCP + 16 * (tid & 15)) = vc1; }
    if (tid < 64) ((LAS unsigned*)(lds + NS_SEL))[tid] = 0u;
    if (tid == 64) ((LAS unsigned*)(lds + NS_UM))[0] = 0u;
    __syncthreads();
    f32x16 out[2];
    {
      f32x16 s[4];
#pragma unroll
      for (int nt = 0; nt < 4; ++nt) {
#pragma unroll
          for (int i = 0; i < 16; ++i) s[nt][i] = 0.f;
#pragma unroll
          for (int st = 0; st < 4; ++st) { const bf16x8 a = *(const LAS bf16x8*)(lds + NS_KC + (32 * nt + r32) * NS_KCP + 32 * st + 16 * h); s[nt] = MFMA32(a, qf[st], s[nt]); } }
      float mx = -1e30f;
#pragma unroll
      for (int nt = 0; nt < 4; ++nt)
#pragma unroll
          for (int i = 0; i < 16; ++i) { const int n = 32 * nt + (i & 3) + 8 * (i >> 2) + 4 * h; const bool ok = (n < 127) && (16 * n + 31 <= qpos); const float v = ok ? s[nt][i] : -1e30f; s[nt][i] = v; mx = fmaxf(mx, v); }
      mx = x32_max(mx);
      float ps = 0.f;
#pragma unroll
      for (int nt = 0; nt < 4; ++nt)
#pragma unroll
          for (int i = 0; i < 16; ++i) { const float v = s[nt][i]; const float pe = (v > -1e29f) ? __builtin_amdgcn_exp2f(v - mx) : 0.f; s[nt][i] = pe; ps += pe; }
      ps = x32_sum(ps);
      const float inv = (ps > 0.f) ? 1.0f / ps : 0.f;
      LAS float* ia = (LAS float*)(lds + NS_IA) + (hd * 64 + ql) * 33; LAS float* ib = (LAS float*)(lds + NS_IB) + (hd * 64 + ql) * 33;
#pragma unroll
      for (int nt = 0; nt < 4; ++nt) {
#pragma unroll
          for (int i = 0; i < 16; ++i) s[nt][i] *= inv;
          if (cur >= 16) {
#pragma unroll
          for (int g = 0; g < 4; ++g) { const int jb = 8 * nt + 2 * g + h; ia[jb] = (s[nt][4 * g] + s[nt][4 * g + 1]) + s[nt][4 * g + 2] + 0.5f * s[nt][4 * g + 3]; ib[jb] = 0.5f * s[nt][4 * g + 3]; } } }
      f32x16 oc[2];
#pragma unroll
      for (int i = 0; i < 16; ++i) { oc[0][i] = 0.f; oc[1][i] = 0.f; }
#pragma unroll
      for (int nt = 0; nt < 4; ++nt)
#pragma unroll
          for (int s2 = 0; s2 < 2; ++s2) {
              u32x4 pw; pw.x = pkbf(s[nt][8 * s2 + 0], s[nt][8 * s2 + 1]); pw.y = pkbf(s[nt][8 * s2 + 2], s[nt][8 * s2 + 3]); pw.z = pkbf(s[nt][8 * s2 + 4], s[nt][8 * s2 + 5]); pw.w = pkbf(s[nt][8 * s2 + 6], s[nt][8 * s2 + 7]);
              const bf16x8 pb = __builtin_bit_cast(bf16x8, pw);
#pragma unroll
              for (int dt = 0; dt < 2; ++dt) { const LAS unsigned char* vp = lds + NS_VC + (32 * dt + r32) * NS_VCP + (32 * nt + 16 * s2 + 4 * h) * 2;
                  const s16x4 lo = *(const LAS s16x4*)vp, hi = *(const LAS s16x4*)(vp + 16);
                  const bf16x8 a = __builtin_shufflevector(lo, hi, 0, 1, 2, 3, 4, 5, 6, 7); oc[dt] = MFMA32(a, pb, oc[dt]); } }
#pragma unroll
      for (int i = 0; i < 16; ++i) { out[0][i] = g0 * oc[0][i]; out[1][i] = g0 * oc[1][i]; }
    }
    __syncthreads();
    if (cur < 16) {
        const unsigned allm = (1u << (cur + 1)) - 1u;
        if (tid < 64) ((LAS unsigned*)(lds + NS_SEL))[tid] = allm;
        if (tid == 64) ((LAS unsigned*)(lds + NS_UM))[0] = allm;
        __syncthreads();
    } else {
    LAS float* impf = (LAS float*)(lds + NS_IF);
    { const int q = tid & 63, jg = tid >> 6;
#pragma unroll
      for (int k = 0; k < 4; ++k) { const int jb = 4 * jg + k; float v = 0.f;
#pragma unroll
          for (int hh = 0; hh < 4; ++hh) { v += ((const LAS float*)(lds + NS_IA))[(hh * 64 + q) * 33 + jb]; if (jb > 0) v += ((const LAS float*)(lds + NS_IB))[(hh * 64 + q) * 33 + jb - 1]; }
          const bool forced = (jb == 0) || (jb == cur) || (jb == cur - 1);
          v = (jb <= cur) ? (v + (forced ? 1000.0f : 0.f)) : -1e30f;
          impf[q * 33 + jb] = v; } }
    __syncthreads();
    { const int q = tid & 63, jg = tid >> 6; unsigned bits = 0u;
      float mine[4];
#pragma unroll
      for (int k = 0; k < 4; ++k) mine[k] = impf[q * 33 + 4 * jg + k];
      int cnt[4] = {0, 0, 0, 0};
      for (int i = 0; i < 32; ++i) { const float vi = impf[q * 33 + i];
#pragma unroll
          for (int k = 0; k < 4; ++k) { const int jb = 4 * jg + k; cnt[k] += ((vi > mine[k]) || (vi == mine[k] && i < jb)) ? 1 : 0; } }
#pragma unroll
      for (int k = 0; k < 4; ++k) if (cnt[k] < 16 && mine[k] > -5e29f) bits |= 1u << (4 * jg + k);
      if (bits) { atomicOr((unsigned*)(lds + NS_SEL) + q, bits); atomicOr((unsigned*)(lds + NS_UM), bits); } }
    __syncthreads();
    }
    const unsigned selm = ((const LAS unsigned*)(lds + NS_SEL))[ql];
    const unsigned um = __builtin_amdgcn_readfirstlane(((const LAS unsigned*)(lds + NS_UM))[0]);
    f32x16 o[2];
    attn_run<1>(lds, p.NKS + (size_t)b * SEQ * 64, p.P + (size_t)b * SEQ * NINP + C_NVS, NINP, nullptr, um, qf, qpos, 0.f, selm, q0w, o);
#pragma unroll
    for (int i = 0; i < 16; ++i) { out[0][i] += g1 * o[0][i]; out[1][i] += g1 * o[1][i]; }
    { const int lo = (cur >= 8) ? (cur - 8) : 0; const unsigned hi_m = (cur >= 31) ? 0xffffffffu : ((1u << (cur + 1)) - 1u); const unsigned wm = hi_m & ~((1u << lo) - 1u);
      attn_run<2>(lds, p.NKW + (size_t)b * SEQ * 64, p.P + (size_t)b * SEQ * NINP + C_NVW, NINP, nullptr, wm, qf, qpos, 0.f, 0u, q0w, o); }
#pragma unroll
    for (int i = 0; i < 16; ++i) { out[0][i] += g2 * o[0][i]; out[1][i] += g2 * o[1][i]; }
    { int qq = qpos, hq = h; asm volatile("" : "+v"(qq), "+v"(hq));
      store_ot(p.O + blk((size_t)b * SEQ + qq, 512 + hd * 64, MTOK), out, hq); }
}

__global__ void __launch_bounds__(NTHR, 2) hybrid_fwd(Args A) {
    extern __shared__ __attribute__((aligned(16))) unsigned char lds_raw[];
    LAS unsigned char* lds = (LAS unsigned char*)lds_raw;
    cg::grid_group grid = cg::this_grid();
    volatile LAS unsigned* bst = (volatile LAS unsigned*)(lds + LDS_BYTES - 16);
    if (threadIdx.x < 4) bst[threadIdx.x] = 0u;
    __syncthreads();
    (void)xcd_barrier_post((unsigned*)(A.ws + WS_CTL), bst);
#define GBAR() do { XcdBarrier b_; { unsigned char* bp_ = A.ws; asm volatile("" : "+s"(bp_)); b_.bar = (unsigned*)(bp_ + WS_CTL); } b_.x = xb_xcc_id(); b_.st = (volatile LAS unsigned*)(lds + LDS_BYTES - 16); xcd_barrier(b_); } while (0)
    const int G = gridDim.x, bx = blockIdx.x;
    unsigned char* ws = A.ws;
    bf16_t* XB = (bf16_t*)(ws + WS_XB); float* SS = (float*)(ws + WS_SSP); bf16_t* R1 = (bf16_t*)(ws + WS_R1); bf16_t* OB = (bf16_t*)(ws + WS_O);
    prologue(A, lds);
    if (A.ws == nullptr) grid.sync();
    GBAR();
#pragma unroll
    for (int l = 0; l < DEPTH; ++l) {
        unsigned char* wl = ws + WS_W + (size_t)l * WL_STRIDE;
#pragma unroll
        for (int f = 0; f < 2; ++f) {
            if (f == 1) {
                {
                    pg8::Gemm g{XB, (const bf16_t*)(wl + WL_WIN), MTOK, NINP, DM}; pg8::StaticOrder S; S.init(MTOK, NINP, G, bx);
                    EpiProj E{R1, SS + (size_t)(3 * l + 1) * MTOK * 16, (float*)(ws + WS_FFB)};
                    pg8::gemm_phase<EpiProj, pg8::StaticOrder, true, true>(lds, g, S, E);
#if DUP == 5
                    GBAR(); pg8::gemm_phase<EpiProj, pg8::StaticOrder, true, true>(lds, g, S, E);
#endif
                }
                GBAR();
                {
                    const LP p = make_lp(A, l);
#if DUP == 2
                    for (int rep = 0; rep < 2; ++rep) {
#endif
                    {
                        unsigned* ctr = (unsigned*)(A.ws + WS_CTL) + 3584 + 64 * (2 + l);
                        volatile LAS unsigned* slot = (volatile LAS unsigned*)(lds + LDS_BYTES - 32);
                        for (;;) {
                            __syncthreads();
                            if (threadIdx.x == 0) slot[0] = atomicAdd(ctr, 1u);
                            __syncthreads();
                            int it = (int)slot[0];
                            if (it >= 256 + 512 + 1024 + 32) break;
                            if (it < 256) prep_cmp(p, it >> 7, (it >> 2) & 31, it & 3, lds);
                            else if (it < 768) { it -= 256; prep_gmlp(p, it >> 4, it & 15, lds); }
                            else if (it < 1792) { it -= 768; prep_tile(p, it >> 5, 64 * (it & 31), lds); }
                            else prep_scan(p, it - 1792, lds);
                        }
                    }
#if DUP == 6
                    for (int it = bx; it < 1024; it += G) prep_tile(p, it >> 5, 64 * (it & 31), lds);
#endif
#if DUP == 7
                    for (int it = bx; it < 512; it += G) prep_gmlp(p, it >> 4, it & 15, lds);
#endif
#if DUP == 8
                    for (int it = bx; it < 256; it += G) prep_cmp(p, it >> 7, (it >> 2) & 31, it & 3, lds);
#endif
#if DUP == 2
                    GBAR(); }
#endif
                }
                GBAR();
                {
                    const LP p = make_lp(A, l);
#if DUP == 3
                    for (int rep = 0; rep < 2; ++rep) {
#endif
                    {
                        unsigned* ctr = (unsigned*)(A.ws + WS_CTL) + 3584 + 64 * l;
                        volatile LAS unsigned* slot = (volatile LAS unsigned*)(lds + LDS_BYTES - 32);
                        for (;;) {
                            __syncthreads();
                            if (threadIdx.x == 0) slot[0] = atomicAdd(ctr, 1u);
                            __syncthreads();
                            const int it = (int)slot[0];
                            if (it >= 2048) break;
                            if (it < 1024) nsa_unit(p, it & 31, 31 - (it >> 5), lds); else { const int fi = it - 1024; fox_unit(p, fi & 127, 7 - (fi >> 7), lds); }
                        }
                    }
#if DUP == 3
                    GBAR(); }
#endif
                }
                GBAR();
                {
                    pg8::Gemm g{OB, (const bf16_t*)(wl + WL_WOUT), MTOK, DM, DM}; pg8::StaticOrder S; S.init(MTOK, DM, G, bx);
                    EpiResid E{nullptr, nullptr, XB, SS + (size_t)(3 * l + 2) * MTOK * 16, 1.0f};
                    pg8::gemm_phase<EpiResid, pg8::StaticOrder, true, true>(lds, g, S, E);
                }
                GBAR();
            }
            {
                pg8::Gemm g{XB, (const bf16_t*)(wl + (f == 0 ? WL_W13A : WL_W13B)), MTOK, 2 * DFF, DM}; pg8::StaticOrder S; S.init(MTOK, 2 * DFF, G, bx);
                EpiSwiGLU E{R1, SS + (size_t)(3 * l + 2 * f) * MTOK * 16};
                pg8::gemm_phase<EpiSwiGLU, pg8::StaticOrder, true, true>(lds, g, S, E);
#if DUP == 4
                GBAR(); pg8::gemm_phase<EpiSwiGLU, pg8::StaticOrder, true, true>(lds, g, S, E);
#endif
#if DUP == 10
                GBAR(); { EpiNull E0{(float*)(ws + WS_R2)}; pg8::gemm_phase<EpiNull, pg8::StaticOrder, true, true>(lds, g, S, E0); }
#endif
            }
            GBAR();
            {
                pg8::Gemm g{R1, (const bf16_t*)(wl + (f == 0 ? WL_W2A : WL_W2B)), MTOK, DM, DFF}; pg8::StaticOrder S; S.init(MTOK, DM, G, bx);
                const bool last = (l == DEPTH - 1) && (f == 1);
                EpiResid E{(l == 0 && f == 0) ? A.in[0] : nullptr, last ? A.out : nullptr, XB, last ? nullptr : SS + (size_t)(3 * l + 1 + 2 * f) * MTOK * 16, 0.5f};
                pg8::gemm_phase<EpiResid, pg8::StaticOrder, true, true>(lds, g, S, E);
            }
            if (!(l == DEPTH - 1 && f == 1)) GBAR();
        }
    }
}

extern "C" void kernel_launch(void* const* d_in, const int* in_sizes, int n_in, void* d_out, int out_size, void* d_ws, size_t ws_size, hipStream_t stream) {
    static int grid = 0;
    if (grid == 0) {
        if (n_in != 31 || out_size != MTOK * DM || ws_size < WS_TOTAL) { fprintf(stderr, "kernel_launch: unexpected shapes (n_in %d out %d ws %zu)\n", n_in, out_size, ws_size); grid = -1; return; }
        int dev = 0, cus = 0, per_cu = 0;
        (void)hipGetDevice(&dev); (void)hipDeviceGetAttribute(&cus, hipDeviceAttributeMultiprocessorCount, dev);
        (void)hipFuncSetAttribute((const void*)hybrid_fwd, hipFuncAttributeMaxDynamicSharedMemorySize, LDS_BYTES);
        (void)hipOccupancyMaxActiveBlocksPerMultiprocessor(&per_cu, (const void*)hybrid_fwd, NTHR, LDS_BYTES);
        if (per_cu < 1) { fprintf(stderr, "kernel_launch: occupancy query says %d blocks per CU\n", per_cu); per_cu = 1; }
        (void)hipGetLastError();
        grid = cus * 1;
        if (grid <= 0) grid = 256;
    }
    if (grid < 0) return;
    if (hipMemsetAsync((char*)d_ws + WS_CTL, 0, WS_CTL_BYTES, stream) != hipSuccess) { fprintf(stderr, "kernel_launch: memset failed\n"); return; }
    Args a{};
    for (int i = 0; i < 31; ++i) a.in[i] = (const float*)d_in[i];
    a.out = (float*)d_out; a.ws = (unsigned char*)d_ws;
    void* params[] = {&a};
    hipError_t e = hipLaunchCooperativeKernel((const void*)hybrid_fwd, dim3(grid), dim3(NTHR), params, LDS_BYTES, stream);
    if (e != hipSuccess) fprintf(stderr, "kernel_launch: cooperative launch failed: %s (grid %d)\n", hipGetErrorString(e), grid);
}
```

```cpp
#include <hip/hip_runtime.h>
#include <hip/hip_cooperative_groups.h>
#include <cstdio>
#include <cstdint>
namespace cg = cooperative_groups;
__device__ __forceinline__ int ltid() { int t = threadIdx.x; asm volatile("" : "+v"(t)); return t; }
namespace pg8 {
#define PG8_LAS __attribute__((address_space(3)))
typedef unsigned short bf16_t;
typedef short bf16x8 __attribute__((ext_vector_type(8)));
typedef float f32x4 __attribute__((ext_vector_type(4)));
typedef unsigned u32x4 __attribute__((ext_vector_type(4)));
constexpr int BM = 256, BK = 64, HALF = 128, HTB = HALF * BK * 2  , STAGE_BYTES = 8 * HTB, NXCD = 8, WGM = 8;

__host__ __device__ __forceinline__ int lds_byte(int r, int c) { const int st = (r >> 4) * 2 + (c >> 5), rr = r & 15, cc = c & 31, ob = rr * 64 + cc * 2; return st * 1024 + (ob ^ (((ob >> 9) & 1) << 5)); }
__host__ __device__ __forceinline__ void stage_rc(int b, int& R, int& C) { const int st = b / 1024, sb = b % 1024, swz = sb ^ (((sb >> 9) & 1) << 5); R = (st >> 1) * 16 + swz / 64; C = (st & 1) * 32 + (swz % 64) / 2; }
__host__ __device__ __forceinline__ int perm32(int rho) { const int n = rho >> 4, i = rho & 15; return 8 * (i >> 2) + 4 * n + (i & 3); }

struct Unit { int pm, pn; };
struct Gemm { const bf16_t* A; const bf16_t* Bt; int M, N, K; };

struct StaticOrder {
    int nM, nN, nwg, G, c;
    __host__ __device__ void init(int M, int N, int G_, int c_) { nM = M / BM; nN = N / BM; nwg = nM * nN; G = G_; c = c_; }
    __host__ __device__ bool next(int i, Unit& u) const {
        const long L = (long)i * G + c; if (L >= nwg) return false;
        int wgid = (int)L; { const int q = nwg / NXCD, r = nwg % NXCD, xcd = wgid % NXCD, off = wgid / NXCD; wgid = (xcd < r ? xcd * (q + 1) : r * (q + 1) + (xcd - r) * q) + off; }
        const int nig = WGM * nN, gid = wgid / nig, fm = gid * WGM, gsz = (nM - fm) < WGM ? (nM - fm) : WGM;
        u.pm = fm + ((wgid % nig) % gsz); u.pn = (wgid % nig) / gsz; return true;
    }
    __device__ __forceinline__ void a_ready(const Unit&) const {}
    __device__ __forceinline__ void done(const Unit&) const {}
};

__device__ __forceinline__ unsigned cvt_pk_bf16(float lo, float hi) { unsigned r; asm volatile("v_cvt_pk_bf16_f32 %0, %1, %2" : "=v"(r) : "v"(lo), "v"(hi)); return r; }
template <class Epi, class Sched, bool ALIGN_EPI = false, bool SP2 = false>
__device__ __forceinline__ void gemm_phase(PG8_LAS unsigned char* lds, const Gemm g, const Sched& S, const Epi& E) {
    const int tid = ltid(), wid = __builtin_amdgcn_readfirstlane(tid >> 6), lane = tid & 63, wr = wid >> 2, wc = wid & 3, fr = lane & 15, fq = lane >> 4;
    const int K = g.K, nt = K / BK;
    unsigned voffA[2], voffB[2];
#pragma unroll
    for (int i = 0; i < 2; ++i) { int R, C; stage_rc(tid * 16 + i * 8192, R, C); const int Rb = Epi::PERM ? ((R & ~31) + perm32(R & 31)) : R;
        voffA[i] = (unsigned)(R * 64 + C) * 2u; voffB[i] = (unsigned)(Rb * 64 + C) * 2u; }
    const size_t kstepA = (size_t)g.M * 128, kstepB = (size_t)g.N * 128;
    const size_t hstep = (size_t)HALF * 128;
    const size_t tstep = 2 * hstep;
    const unsigned ldsw = (unsigned)wid * 1024u;
    const int aoff = lds_byte(wr * 64 + fr, fq * 8), boff = lds_byte(wc * 32 + fr, fq * 8);
#define PG8_SA(b, h) (((b) * 2 + (h)) * HTB)
#define PG8_SB(b, h) ((4 + (b) * 2 + (h)) * HTB)
#define PG8_STAGE(bufoff, gbase, voff) do { _Pragma("unroll") for (int _i = 0; _i < 2; ++_i) \
        __builtin_amdgcn_global_load_lds((const unsigned*)((const char*)(gbase) + (voff)[_i]), (PG8_LAS unsigned*)(lds + (bufoff) + ldsw + _i * 8192), 16, 0, 0); } while (0)
#define PG8_LDA(dst, b, h) do { _Pragma("unroll") for (int m = 0; m < 4; ++m) _Pragma("unroll") for (int k = 0; k < 2; ++k) dst[m][k] = *(const PG8_LAS bf16x8*)(lds + PG8_SA(b, h) + aoff + m * 2048 + k * 1024); } while (0)
#define PG8_LDB(dst, b, h) do { _Pragma("unroll") for (int n = 0; n < 2; ++n) _Pragma("unroll") for (int k = 0; k < 2; ++k) dst[n][k] = *(const PG8_LAS bf16x8*)(lds + PG8_SB(b, h) + boff + n * 2048 + k * 1024); } while (0)
#define PG8_MMA(ai, bj, At, Bt) do { __builtin_amdgcn_s_setprio(1); _Pragma("unroll") for (int m = 0; m < 4; ++m) _Pragma("unroll") for (int n = 0; n < 2; ++n) _Pragma("unroll") for (int k = 0; k < 2; ++k) \
        acc[ai][bj][m][n] = __builtin_amdgcn_mfma_f32_16x16x32_bf16(Bt[n][k], At[m][k], acc[ai][bj][m][n], 0, 0, 0); __builtin_amdgcn_s_setprio(0); } while (0)
#define PG8_WAIT_V(n) asm volatile("s_waitcnt vmcnt(" #n ")" ::: "memory")
#define PG8_WAIT_L(n) asm volatile("s_waitcnt lgkmcnt(" #n ")" ::: "memory")
#define PG8_BAR __builtin_amdgcn_s_barrier()
#define PG8_SCHED __builtin_amdgcn_sched_barrier(0)
    Unit cur, nxt; int ui = 0;
    if (!S.next(0, cur)) return;
    f32x4 acc[2][2][4][2];
#pragma unroll
    for (int a = 0; a < 2; ++a)
#pragma unroll
        for (int b = 0; b < 2; ++b)
#pragma unroll
            for (int m = 0; m < 4; ++m)
#pragma unroll
                for (int n = 0; n < 2; ++n) acc[a][b][m][n] = (f32x4){0.f, 0.f, 0.f, 0.f};
    bf16x8 At[4][2], B0[2][2], B1[2][2];
    const char* cA = (const char*)g.A + (size_t)cur.pm * tstep; const char* cB = (const char*)g.Bt + (size_t)cur.pn * tstep;
    S.a_ready(cur);
    if constexpr (SP2) {
        PG8_STAGE(PG8_SB(0, 0), cB, voffB); PG8_STAGE(PG8_SB(0, 1), cB + hstep, voffB); PG8_STAGE(PG8_SA(0, 0), cA, voffA); PG8_STAGE(PG8_SA(0, 1), cA + hstep, voffA);
        if (wr == 1) PG8_BAR;
        PG8_WAIT_V(2); PG8_BAR;
        PG8_STAGE(PG8_SB(1, 0), cB + kstepB, voffB); PG8_STAGE(PG8_SA(1, 0), cA + kstepA, voffA); PG8_STAGE(PG8_SB(1, 1), cB + hstep + kstepB, voffB);
        PG8_WAIT_V(6); PG8_BAR;
    } else {
        PG8_STAGE(PG8_SB(0, 0), cB, voffB); PG8_STAGE(PG8_SA(0, 0), cA, voffA); PG8_STAGE(PG8_SB(0, 1), cB + hstep, voffB); PG8_STAGE(PG8_SA(0, 1), cA + hstep, voffA);
        if (wr == 1) PG8_BAR;
        PG8_WAIT_V(4); PG8_BAR;
        PG8_STAGE(PG8_SB(1, 0), cB + kstepB, voffB); PG8_STAGE(PG8_SA(1, 0), cA + kstepA, voffA); PG8_STAGE(PG8_SB(1, 1), cB + hstep + kstepB, voffB);
        PG8_WAIT_V(6); PG8_BAR;
    }
    for (;;) {
        const bool has_next = S.next(ui + 1, nxt);
        const char* nA = has_next ? (const char*)g.A + (size_t)nxt.pm * tstep : cA; const char* nB = has_next ? (const char*)g.Bt + (size_t)nxt.pn * tstep : cB;
        for (int t = 0; t < nt; t += 2) {
            const bool last = (t == nt - 2);
            const char* a1 = cA + (size_t)(t + 1) * kstepA;
            const char* a2 = last ? nA : cA + (size_t)(t + 2) * kstepA; const char* b2 = last ? nB : cB + (size_t)(t + 2) * kstepB;
            const char* a3 = a2 + kstepA; const char* b3 = b2 + kstepB;
            if (last && has_next) S.a_ready(nxt);
            if constexpr (SP2) {
            PG8_LDB(B0, 0, 0); PG8_LDB(B1, 0, 1); PG8_SCHED; PG8_LDA(At, 0, 0); PG8_STAGE(PG8_SA(1, 1), a1 + hstep, voffA);
            PG8_WAIT_V(8); PG8_WAIT_L(0); PG8_BAR; PG8_MMA(0, 0, At, B0); PG8_MMA(0, 1, At, B1); PG8_BAR; PG8_SCHED;
            PG8_LDA(At, 0, 1); PG8_STAGE(PG8_SB(0, 0), b2, voffB); PG8_STAGE(PG8_SB(0, 1), b2 + hstep, voffB); PG8_STAGE(PG8_SA(0, 0), a2, voffA);
            PG8_WAIT_V(8); PG8_WAIT_L(0); PG8_BAR; PG8_MMA(1, 0, At, B0); PG8_MMA(1, 1, At, B1); PG8_BAR; PG8_SCHED;
            PG8_LDB(B0, 1, 0); PG8_LDB(B1, 1, 1); PG8_SCHED; PG8_LDA(At, 1, 0); PG8_STAGE(PG8_SA(0, 1), a2 + hstep, voffA);
            PG8_WAIT_V(8); PG8_WAIT_L(0); PG8_BAR; PG8_MMA(0, 0, At, B0); PG8_MMA(0, 1, At, B1); PG8_BAR; PG8_SCHED;
            PG8_LDA(At, 1, 1); PG8_STAGE(PG8_SB(1, 0), b3, voffB); PG8_STAGE(PG8_SB(1, 1), b3 + hstep, voffB); PG8_STAGE(PG8_SA(1, 0), a3, voffA);
            PG8_WAIT_V(8); PG8_WAIT_L(0); PG8_BAR; PG8_MMA(1, 0, At, B0); PG8_MMA(1, 1, At, B1); PG8_BAR; PG8_SCHED;
            } else {
            PG8_LDB(B0, 0, 0); PG8_SCHED; PG8_LDA(At, 0, 0); PG8_STAGE(PG8_SA(1, 1), a1 + hstep, voffA);
            PG8_WAIT_L(8); PG8_BAR; PG8_WAIT_L(0); PG8_MMA(0, 0, At, B0); PG8_BAR; PG8_SCHED;
            PG8_LDB(B1, 0, 1); PG8_STAGE(PG8_SB(0, 0), b2, voffB);
            PG8_BAR; PG8_WAIT_L(0); PG8_MMA(0, 1, At, B1); PG8_BAR;
            PG8_LDA(At, 0, 1); PG8_STAGE(PG8_SA(0, 0), a2, voffA);
            PG8_BAR; PG8_WAIT_L(0); PG8_MMA(1, 0, At, B0); PG8_BAR; PG8_SCHED;
            PG8_STAGE(PG8_SB(0, 1), b2 + hstep, voffB);
            PG8_WAIT_V(6); PG8_BAR; PG8_MMA(1, 1, At, B1); PG8_BAR;
            PG8_LDB(B0, 1, 0); PG8_SCHED; PG8_LDA(At, 1, 0); PG8_STAGE(PG8_SA(0, 1), a2 + hstep, voffA);
            PG8_WAIT_L(8); PG8_BAR; PG8_WAIT_L(0); PG8_MMA(0, 0, At, B0); PG8_BAR; PG8_SCHED;
            PG8_LDB(B1, 1, 1); PG8_STAGE(PG8_SB(1, 0), b3, voffB);
            PG8_BAR; PG8_WAIT_L(0); PG8_MMA(0, 1, At, B1); PG8_BAR;
            PG8_LDA(At, 1, 1); PG8_STAGE(PG8_SA(1, 0), a3, voffA);
            PG8_BAR; PG8_WAIT_L(0); PG8_MMA(1, 0, At, B0); PG8_BAR; PG8_SCHED;
            PG8_STAGE(PG8_SB(1, 1), b3 + hstep, voffB);
            PG8_WAIT_V(6); PG8_BAR; PG8_MMA(1, 1, At, B1); PG8_BAR;
            }
        }
        if constexpr (ALIGN_EPI) { if (wr == 0) PG8_BAR; }
        if constexpr (!Epi::AFTER_DRAIN) { E(acc, cur, wr, wc, fr, fq); S.done(cur); }
        if (!has_next) break;
#pragma unroll
        for (int a = 0; a < 2; ++a)
#pragma unroll
            for (int b = 0; b < 2; ++b)
#pragma unroll
                for (int m = 0; m < 4; ++m)
#pragma unroll
                    for (int n = 0; n < 2; ++n) acc[a][b][m][n] = (f32x4){0.f, 0.f, 0.f, 0.f};
        cur = nxt; cA = nA; cB = nB; ++ui;
        if constexpr (ALIGN_EPI) { if (wr == 1) PG8_BAR; }
    }
    PG8_WAIT_V(0);
    if constexpr (!ALIGN_EPI) { if (wr == 0) PG8_BAR; }
    PG8_BAR;
    if constexpr (Epi::AFTER_DRAIN) { E.fused(acc, cur, wr, wc, fr, fq, lds, wid, lane); S.done(cur); }
#undef PG8_SA
#undef PG8_SB
#undef PG8_STAGE
#undef PG8_LDA
#undef PG8_LDB
#undef PG8_MMA
#undef PG8_WAIT_V
#undef PG8_WAIT_L
#undef PG8_BAR
#undef PG8_SCHED
}
}

using pg8::bf16_t; using pg8::bf16x8; using pg8::f32x4; using pg8::u32x4;
#define LAS __attribute__((address_space(3)))
typedef short s16x4 __attribute__((ext_vector_type(4)));
typedef float f32x16 __attribute__((ext_vector_type(16)));
typedef unsigned u32x2 __attribute__((ext_vector_type(2)));
#define MFMA32(a, b, c) __builtin_amdgcn_mfma_f32_32x32x16_bf16((a), (b), (c), 0, 0, 0)
#define MFMA16(a, b, c) __builtin_amdgcn_mfma_f32_16x16x32_bf16((a), (b), (c), 0, 0, 0)
#define LDS_WAIT() asm volatile("s_waitcnt lgkmcnt(0)" ::: "memory")
#define SCHED_FENCE() __builtin_amdgcn_sched_barrier(0)

#ifndef DUP
#define DUP 0
#endif
constexpr int BATCH = 32, SEQ = 2048, DM = 1024, MTOK = BATCH * SEQ, DFF = 2816, NIN = 2192, NINP = 2304, DEPTH = 2, NTHR = 512, NWAVE = 8;
constexpr float EPS = 1e-6f, LOG2E = 1.4426950408889634f, QSCALE = 0.125f * LOG2E;
constexpr int C_FQ = 0, C_FK = 256, C_FV = 512, C_GU = 768, C_GV = 1024, C_NQ = 1280, C_NKC = 1536, C_NVC = 1600, C_NKS = 1664, C_NVS = 1728, C_NKW = 1792, C_NVW = 1856, C_PZ = 1920, C_FF = 2176, C_NG = 2180;
constexpr int LDS_BYTES = 147456;
constexpr size_t KiB = 1024, MiB = 1u << 20;
constexpr size_t WL_W13A = 0, WL_W2A = 11 * MiB, WL_WIN = WL_W2A + 5632 * KiB, WL_WOUT = 21 * MiB, WL_W13B = 23 * MiB, WL_W2B = 34 * MiB, WL_CK1 = WL_W2B + 5632 * KiB, WL_CV1 = WL_CK1 + MiB,
                 WL_CK2 = WL_CV1 + MiB, WL_CV2 = WL_CK2 + 32 * KiB, WL_GWS = WL_CV2 + 32 * KiB, WL_PWT = WL_GWS + 128 * KiB, WL_STRIDE = 42 * MiB;
static_assert(WL_PWT + 32 * KiB <= WL_STRIDE, "weights map");
constexpr size_t WS_W = 0, WS_XB = 84 * MiB, WS_SS = 212 * MiB, WS_R1 = 214 * MiB, WS_R2 = 566 * MiB;
constexpr size_t WS_FQ = WS_R2, WS_FK = WS_FQ + 32 * MiB, WS_FVT = WS_FK + 32 * MiB, WS_NQ = WS_FVT + 32 * MiB, WS_NKS = WS_NQ + 32 * MiB, WS_NVST = WS_NKS + 8 * MiB, WS_NKW = WS_NVST + 8 * MiB,
                 WS_NVWT = WS_NKW + 8 * MiB, WS_FC = WS_NVWT + 8 * MiB, WS_NG = WS_FC + MiB, WS_KCMP = WS_NG + 3 * MiB, WS_VCMPT = WS_KCMP + 512 * KiB, WS_O = WS_VCMPT + 512 * KiB, WS_END = WS_O + 128 * MiB;
constexpr size_t WS_CTL = WS_END, WS_CTL_BYTES = 16384, WS_FFB = WS_END + MiB, WS_SSP = WS_FFB + MiB, WS_ROPE = WS_SSP + 24 * MiB, WS_TOTAL = WS_ROPE + MiB;
static_assert(WS_TOTAL <= 1024 * MiB && 3456 * 4 <= (int)WS_CTL_BYTES, "ws map");

struct Args { const float* in[31]; float* out; unsigned char* ws; };

__device__ __forceinline__ unsigned pkbf(float lo, float hi) {
    typedef float f2 __attribute__((ext_vector_type(2))); typedef __bf16 b2 __attribute__((ext_vector_type(2)));
    f2 v = {lo, hi}; b2 b = __builtin_convertvector(v, b2); return __builtin_bit_cast(unsigned, b);
}
__device__ __forceinline__ size_t blk(size_t r, int k, size_t rows) { return ((size_t)(k >> 6) * rows + r) * 64 + (k & 63); }
__device__ __forceinline__ float bflo(unsigned u) { return __uint_as_float(u << 16); }
__device__ __forceinline__ float bfhi(unsigned u) { return __uint_as_float(u & 0xffff0000u); }
__device__ __forceinline__ float gelu_t(float x) { const float y = 0.7978845608028654f * (x + 0.044715f * x * x * x); return x * __builtin_amdgcn_rcpf(1.f + __expf(-2.f * y)); }
__device__ __forceinline__ float x32_max(float x) { auto t = __builtin_amdgcn_permlane32_swap(__float_as_uint(x), __float_as_uint(x), false, false); return fmaxf(__uint_as_float(t[0]), __uint_as_float(t[1])); }
__device__ __forceinline__ float x32_sum(float x) { auto t = __builtin_amdgcn_permlane32_swap(__float_as_uint(x), __float_as_uint(x), false, false); return __uint_as_float(t[0]) + __uint_as_float(t[1]); }
__device__ __forceinline__ float x1632_sum(float x) {
    auto s = __builtin_amdgcn_permlane16_swap(__float_as_uint(x), __float_as_uint(x), false, false); x = __uint_as_float(s[0]) + __uint_as_float(s[1]);
    auto t = __builtin_amdgcn_permlane32_swap(__float_as_uint(x), __float_as_uint(x), false, false); return __uint_as_float(t[0]) + __uint_as_float(t[1]); }
__device__ __forceinline__ float wave_sum(float v) {
#pragma unroll
    for (int o = 1; o < 64; o <<= 1) v += __shfl_xor(v, o);
    return v;
}

#define XB_TMO      128
#define XB_XCNT(j)  (256  + 64 * (j))
#define XB_XSUB(j)  (1280 + 64 * (j))
#define XB_XGEN(j)  (2304 + 64 * (j))
#define XB_TOP      3328
#define XB_TOPGEN   3392
#define XCD_BAR_WORDS 3456
#define XB_SPIN_CAP (1u << 18)

__device__ __forceinline__ unsigned xb_ld(unsigned* p)              { return __hip_atomic_load(p, __ATOMIC_RELAXED, __HIP_MEMORY_SCOPE_AGENT); }
__device__ __forceinline__ unsigned xb_add(unsigned* p, unsigned v) { return __hip_atomic_fetch_add(p, v, __ATOMIC_RELAXED, __HIP_MEMORY_SCOPE_AGENT); }
__device__ __forceinline__ unsigned xb_xcc_id() { return (unsigned)__builtin_amdgcn_s_getreg((3 << 11) | 20) & 0xFu; }
#define XB_SPIN(cond, bar) do { unsigned _sp = 0; while (cond) { __builtin_amdgcn_s_sleep(1); \
    if ((++_sp & 255u) == 0u) { if (xb_ld(&(bar)[XB_TMO])) break; if (_sp > XB_SPIN_CAP) { atomicAdd(&(bar)[XB_TMO], 1u); break; } } } } while (0)

struct XcdBarrier {
    unsigned* bar; unsigned x;
    volatile LAS unsigned* st;
};

__device__ __forceinline__ XcdBarrier xcd_barrier_post(unsigned* bar, volatile LAS unsigned* st) {
    XcdBarrier b; b.bar = bar; b.x = xb_xcc_id(); b.st = st;
    if (threadIdx.x == 0) (void)xb_add(&bar[XB_XCNT(b.x)], 1u);
    return b;
}
__device__ __forceinline__ void xcd_barrier_complete(unsigned* bar, unsigned x, unsigned& nloc, unsigned& nx) {
    const unsigned G = gridDim.x * gridDim.y * gridDim.z;
    unsigned sum, cnt, mine, sp = 0u;
    for (;;) {
        sum = 0u; cnt = 0u; mine = 0u;
#pragma unroll
        for (unsigned j = 0; j < 16; ++j) { const unsigned c = xb_ld(&bar[XB_XCNT(j)]); sum += c; cnt += (c > 0u) ? 1u : 0u; mine = (j == x) ? c : mine; }
        if (sum == G) break;
        __builtin_amdgcn_s_sleep(1);
        if ((++sp & 255u) == 0u) { if (xb_ld(&bar[XB_TMO])) break; if (sp > XB_SPIN_CAP) { atomicAdd(&bar[XB_TMO], 1u); break; } }
    }
    nloc = mine > 0u ? mine : 1u; nx = cnt > 0u ? cnt : 1u;
}

__device__ __forceinline__ void xcd_barrier(const XcdBarrier& b) {
    asm volatile("s_waitcnt vmcnt(0)" ::: "memory");
    __syncthreads();
    if (threadIdx.x == 0) {
        unsigned* bar = b.bar;
        __builtin_amdgcn_s_waitcnt(0);
        unsigned nloc = b.st[0], nx = b.st[1];
        if (nloc == 0u) { xcd_barrier_complete(bar, b.x, nloc, nx); b.st[0] = nloc; b.st[1] = nx; }
        const unsigned old = xb_add(&bar[XB_XSUB(b.x)], 1u);
        const unsigned gen = old / nloc;
        if (old + 1u == (gen + 1u) * nloc) {
            __builtin_amdgcn_fence(__ATOMIC_RELEASE, "agent");
            asm volatile("s_waitcnt vmcnt(0)" ::: "memory");
            const unsigned og = xb_add(&bar[XB_TOP], 1u);
            const unsigned tg = og / nx;
            if (og + 1u == (tg + 1u) * nx) xb_add(&bar[XB_TOPGEN], 1u);
            else XB_SPIN(xb_ld(&bar[XB_TOPGEN]) == tg, bar);
            __builtin_amdgcn_fence(__ATOMIC_ACQUIRE, "agent");
            xb_add(&bar[XB_XGEN(b.x)], 1u);
            asm volatile("s_waitcnt vmcnt(0)" ::: "memory");
        } else {
            XB_SPIN(xb_ld(&bar[XB_XGEN(b.x)]) == gen, bar);
            __builtin_amdgcn_fence(__ATOMIC_ACQUIRE, "agent");
            asm volatile("s_waitcnt vmcnt(0)" ::: "memory");
        }
    }
    __syncthreads();
}

__device__ __forceinline__ float rs_from_partials(const f32x4 (&q)[4]) {
    const f32x4 t = (q[0] + q[1]) + (q[2] + q[3]); const float s = (t[0] + t[1]) + (t[2] + t[3]);
    return rsqrtf(s * (1.0f / DM) + EPS);
}
struct EpiSwiGLU {
    static constexpr bool PERM = true, AFTER_DRAIN = false;
    bf16_t* ACT; const float* ss;
    __device__ __forceinline__ void operator()(const f32x4 (&acc)[2][2][4][2], const pg8::Unit& u, int wr, int wc, int fr, int fq) const {
        const int row0 = u.pm * 256 + wr * 64 + fr, col0 = u.pn * 128 + wc * 32 + 8 * fq;
        f32x4 pq[2][4]; float rsv[2][4];
#pragma unroll
        for (int ai = 0; ai < 2; ++ai)
#pragma unroll
            for (int m = 0; m < 4; ++m) pq[ai][m] = *(const f32x4*)(ss + (size_t)(row0 + ai * 128 + m * 16) * 16 + 4 * fq);
        SCHED_FENCE();
#pragma unroll
        for (int ai = 0; ai < 2; ++ai)
#pragma unroll
            for (int m = 0; m < 4; ++m) { const f32x4 t = pq[ai][m]; float s = (t[0] + t[1]) + (t[2] + t[3]); s = x1632_sum(s); rsv[ai][m] = rsqrtf(s * (1.0f / DM) + EPS); }
#pragma unroll
        for (int ai = 0; ai < 2; ++ai) {
#pragma unroll
            for (int m = 0; m < 4; ++m) {
                const int row = row0 + ai * 128 + m * 16;
                const float rs = rsv[ai][m];
                typedef float f32x2e __attribute__((ext_vector_type(2)));
                const float kk = -rs * LOG2E, rs2 = rs * rs;
                f32x2e o2[4];
#pragma unroll
                for (int n = 0; n < 2; ++n)
#pragma unroll
                    for (int e = 0; e < 2; ++e) { const f32x2e a = {acc[ai][0][m][n][2 * e], acc[ai][0][m][n][2 * e + 1]}, bq = {acc[ai][1][m][n][2 * e], acc[ai][1][m][n][2 * e + 1]};
                        f32x2e ex = a * kk; ex.x = __builtin_amdgcn_exp2f(ex.x); ex.y = __builtin_amdgcn_exp2f(ex.y);
                        f32x2e d = ex + 1.0f; d.x = __builtin_amdgcn_rcpf(d.x); d.y = __builtin_amdgcn_rcpf(d.y);
                        o2[2 * n + e] = ((a * bq) * d) * rs2; }
                u32x4 w; w.x = pkbf(o2[0].x, o2[0].y); w.y = pkbf(o2[1].x, o2[1].y); w.z = pkbf(o2[2].x, o2[2].y); w.w = pkbf(o2[3].x, o2[3].y);
                *(u32x4*)(ACT + blk(row, col0, MTOK)) = w;
            }
            SCHED_FENCE();
        }
    }
};
struct EpiResid {
    static constexpr bool PERM = true, AFTER_DRAIN = false;
    const float* base32; float* out32; bf16_t* xb; float* ssn; float alpha;
    __device__ __forceinline__ void operator()(const f32x4 (&acc)[2][2][4][2], const pg8::Unit& u, int wr, int wc, int fr, int fq) const {
        const int row0 = u.pm * 256 + wr * 64 + fr, col0 = u.pn * 256 + wc * 32 + 8 * fq;
        if (base32) {
#pragma unroll
            for (int ai = 0; ai < 2; ++ai) {
                f32x4 bv[4][2][2];
#pragma unroll
                for (int m = 0; m < 4; ++m)
#pragma unroll
                    for (int bj = 0; bj < 2; ++bj) { const size_t off = (size_t)(row0 + ai * 128 + m * 16) * DM + col0 + bj * 128; bv[m][bj][0] = *(const f32x4*)(base32 + off); bv[m][bj][1] = *(const f32x4*)(base32 + off + 4); }
                SCHED_FENCE();
#pragma unroll
                for (int m = 0; m < 4; ++m) {
                    const int row = row0 + ai * 128 + m * 16; float sq = 0.f;
#pragma unroll
                    for (int bj = 0; bj < 2; ++bj) {
                        const f32x4 v0 = bv[m][bj][0] + acc[ai][bj][m][0] * alpha, v1 = bv[m][bj][1] + acc[ai][bj][m][1] * alpha;
                        u32x4 w; w.x = pkbf(v0[0], v0[1]); w.y = pkbf(v0[2], v0[3]); w.z = pkbf(v1[0], v1[1]); w.w = pkbf(v1[2], v1[3]); *(u32x4*)(xb + blk(row, col0 + bj * 128, MTOK)) = w;
                        sq += (v0[0] * v0[0] + v0[1] * v0[1]) + (v0[2] * v0[2] + v0[3] * v0[3]) + (v1[0] * v1[0] + v1[1] * v1[1]) + (v1[2] * v1[2] + v1[3] * v1[3]);
                    }
                    sq = x1632_sum(sq); if (fq == 0) ssn[(size_t)row * 16 + u.pn * 4 + wc] = sq;
                }
                SCHED_FENCE();
            }
        } else {
#pragma unroll
            for (int ai = 0; ai < 2; ++ai) {
                u32x4 bw[4][2];
#pragma unroll
                for (int m = 0; m < 4; ++m)
#pragma unroll
                    for (int bj = 0; bj < 2; ++bj) bw[m][bj] = *(const u32x4*)(xb + blk(row0 + ai * 128 + m * 16, col0 + bj * 128, MTOK));
                SCHED_FENCE();
#pragma unroll
                for (int m = 0; m < 4; ++m) {
                    const int row = row0 + ai * 128 + m * 16; float sq = 0.f;
#pragma unroll
                    for (int bj = 0; bj < 2; ++bj) {
                        const u32x4 b = bw[m][bj];
                        const f32x4 b0 = {bflo(b.x), bfhi(b.x), bflo(b.y), bfhi(b.y)}, b1 = {bflo(b.z), bfhi(b.z), bflo(b.w), bfhi(b.w)};
                        const f32x4 v0 = b0 + acc[ai][bj][m][0] * alpha, v1 = b1 + acc[ai][bj][m][1] * alpha;
                        if (out32) { const size_t off = (size_t)row * DM + col0 + bj * 128; *(f32x4*)(out32 + off) = v0; *(f32x4*)(out32 + off + 4) = v1; }
                        else { u32x4 w; w.x = pkbf(v0[0], v0[1]); w.y = pkbf(v0[2], v0[3]); w.z = pkbf(v1[0], v1[1]); w.w = pkbf(v1[2], v1[3]); *(u32x4*)(xb + blk(row, col0 + bj * 128, MTOK)) = w;
                            sq += (v0[0] * v0[0] + v0[1] * v0[1]) + (v0[2] * v0[2] + v0[3] * v0[3]) + (v1[0] * v1[0] + v1[1] * v1[1]) + (v1[2] * v1[2] + v1[3] * v1[3]); }
                    }
                    if (!out32) { sq = x1632_sum(sq); if (fq == 0) ssn[(size_t)row * 16 + u.pn * 4 + wc] = sq; }
                }
                SCHED_FENCE();
            }
        }
    }
};
struct EpiNull {
    static constexpr bool PERM = true, AFTER_DRAIN = false;
    float* dump;
    __device__ __forceinline__ void operator()(const f32x4 (&acc)[2][2][4][2], const pg8::Unit& u, int wr, int wc, int fr, int fq) const {
        f32x4 s = {0.f, 0.f, 0.f, 0.f};
#pragma unroll
        for (int ai = 0; ai < 2; ++ai)
#pragma unroll
            for (int bj = 0; bj < 2; ++bj)
#pragma unroll
                for (int m = 0; m < 4; ++m) s += acc[ai][bj][m][0] + acc[ai][bj][m][1];
        *(f32x4*)(dump + ((size_t)blockIdx.x * 512 + threadIdx.x) * 4) = s;
    }
};
struct EpiProj {
    static constexpr bool PERM = true, AFTER_DRAIN = false;
    bf16_t* P; const float* ss; float* FFB;
    __device__ __forceinline__ void operator()(const f32x4 (&acc)[2][2][4][2], const pg8::Unit& u, int wr, int wc, int fr, int fq) const {
        const int row0 = u.pm * 256 + wr * 64 + fr, col0 = u.pn * 256 + wc * 32 + 8 * fq;
        f32x4 pq[2][4]; float rsv[2][4];
#pragma unroll
        for (int ai = 0; ai < 2; ++ai)
#pragma unroll
            for (int m = 0; m < 4; ++m) pq[ai][m] = *(const f32x4*)(ss + (size_t)(row0 + ai * 128 + m * 16) * 16 + 4 * fq);
        SCHED_FENCE();
#pragma unroll
        for (int ai = 0; ai < 2; ++ai)
#pragma unroll
            for (int m = 0; m < 4; ++m) { const f32x4 t = pq[ai][m]; float s = (t[0] + t[1]) + (t[2] + t[3]); s = x1632_sum(s); rsv[ai][m] = rsqrtf(s * (1.0f / DM) + EPS); }
#pragma unroll
        for (int ai = 0; ai < 2; ++ai) {
#pragma unroll
            for (int m = 0; m < 4; ++m) {
                const int row = row0 + ai * 128 + m * 16;
                const float rs = rsv[ai][m];
#pragma unroll
                for (int bj = 0; bj < 2; ++bj) {
                    const f32x4 v0 = acc[ai][bj][m][0] * rs, v1 = acc[ai][bj][m][1] * rs;
                    u32x4 w; w.x = pkbf(v0[0], v0[1]); w.y = pkbf(v0[2], v0[3]); w.z = pkbf(v1[0], v1[1]); w.w = pkbf(v1[2], v1[3]);
                    *(u32x4*)(P + (size_t)row * NINP + col0 + bj * 128) = w;
                    if (bj == 1 && u.pn == 8 && wc == 0 && fq == 0) *(f32x4*)(FFB + (size_t)row * 4) = v0;
                }
            }
            SCHED_FENCE();
        }
    }
};

__device__ __forceinline__ float rope_inv(int i) {
    const float t[8] = {1.0f, 0.1939227432012558f, 0.03760603070259094f, 0.007292664609849453f, 0.0014142135623842478f, 0.00027424818836152554f, 5.318296098266728e-05f, 1.0313386155758053e-05f};
    float r = t[0];
#pragma unroll
    for (int k = 1; k < 8; ++k) r = (i == k) ? t[k] : r;
    return r;
}

__device__ __forceinline__ void tr_item(const float* ja, const float* jb_, const float* gain, bf16_t* dst, const int N, const int mode, const int K, const int Nd, const bool blocked, LAS float* scr, int item, int lane) {
    const int nblk = Nd >> 5, kb = item / nblk, nb = item - kb * nblk, k0 = 64 * kb, n0 = 32 * nb, kr = lane >> 3, c4 = lane & 7;
    const float* cp; int stride;
    { const int n = n0 + 4 * c4;
      if (mode == 0) { cp = ja + n; stride = N; }
      else if (mode == 1) { const int pn = n >> 8, wi = n & 255; cp = ((wi < 128) ? ja : jb_) + pn * 128 + (wi & 127); stride = DFF; }
      else { int s; if (n < 768) s = n; else if (n < 1920) s = n + 4; else if (n < 2176) s = n + 16; else if (n < 2180) s = 768 + (n - 2176); else if (n < 2192) s = 1924 + (n - 2180); else s = -1;
             cp = (s >= 0) ? ja + s : nullptr; stride = NIN; } }
    f32x4 v[8];
#pragma unroll
    for (int i = 0; i < 8; ++i) { const int k = k0 + 8 * i + kr; v[i] = cp ? *(const f32x4*)(cp + (size_t)k * stride) : (f32x4){0.f, 0.f, 0.f, 0.f}; if (gain) v[i] = v[i] * gain[k]; }
#pragma unroll
    for (int i = 0; i < 8; ++i) { LAS float* w = scr + (8 * i + kr) * 33 + 4 * c4; w[0] = v[i][0]; w[1] = v[i][1]; w[2] = v[i][2]; w[3] = v[i][3]; }
    LDS_WAIT();
    const int c = lane & 7;
#pragma unroll
    for (int j = 0; j < 4; ++j) { const int n = (lane >> 3) + 8 * j; const LAS float* s = scr + (8 * c) * 33 + n;
        u32x4 o; o.x = pkbf(s[0], s[33]); o.y = pkbf(s[66], s[99]); o.z = pkbf(s[132], s[165]); o.w = pkbf(s[198], s[231]);
        *(u32x4*)(dst + (blocked ? ((size_t)kb * Nd + n0 + n) * 64 + 8 * c : (size_t)(n0 + n) * K + k0 + 8 * c)) = o; }
    LDS_WAIT();
}
constexpr int PJ_TOT = 10648;
__device__ __forceinline__ void prologue(const Args& A, LAS unsigned char* lds) {
    const int tid = ltid(), lane = tid & 63, wave = tid >> 6;
    const int gw = blockIdx.x * NWAVE + wave, NGW = gridDim.x * NWAVE;
    LAS float* scr = (LAS float*)(lds + wave * 16384);
    for (int it = gw; it < DEPTH * PJ_TOT; it += NGW) {
        const int l = (it >= PJ_TOT) ? 1 : 0; int r = it - l * PJ_TOT;
        unsigned char* wl = A.ws + WS_W + (size_t)l * WL_STRIDE;
        const float* ja; const float* jb_ = nullptr; const float* gain = nullptr; unsigned char* dst; int N, mode = 0, K, Nd; const bool blocked = (r < 10112);
        if (r < 2816) { ja = A.in[2] + (size_t)l * DM * DFF; jb_ = A.in[3] + (size_t)l * DM * DFF; gain = A.in[1] + l * DM; dst = wl + WL_W13A; N = DFF; mode = 1; K = DM; Nd = 2 * DFF; }
        else if (r < 4224) { r -= 2816; ja = A.in[4] + (size_t)l * DFF * DM; dst = wl + WL_W2A; N = DM; K = DFF; Nd = DM; }
        else if (r < 5376) { r -= 4224; ja = A.in[6] + (size_t)l * DM * NIN; gain = A.in[5] + l * DM; dst = wl + WL_WIN; N = NIN; mode = 2; K = DM; Nd = NINP; }
        else if (r < 5888) { r -= 5376; ja = A.in[7] + (size_t)l * DM * DM; dst = wl + WL_WOUT; N = DM; K = DM; Nd = DM; }
        else if (r < 8704) { r -= 5888; ja = A.in[28] + (size_t)l * DM * DFF; jb_ = A.in[29] + (size_t)l * DM * DFF; gain = A.in[27] + l * DM; dst = wl + WL_W13B; N = DFF; mode = 1; K = DM; Nd = 2 * DFF; }
        else if (r < 10112) { r -= 8704; ja = A.in[30] + (size_t)l * DFF * DM; dst = wl + WL_W2B; N = DM; K = DFF; Nd = DM; }
        else if (r < 10368) { r -= 10112; ja = A.in[19] + (size_t)l * 2048 * 256; dst = wl + WL_CK1; N = 256; K = 2048; Nd = 256; }
        else if (r < 10624) { r -= 10368; ja = A.in[22] + (size_t)l * 2048 * 256; dst = wl + WL_CV1; N = 256; K = 2048; Nd = 256; }
        else if (r < 10632) { r -= 10624; ja = A.in[20] + (size_t)l * 256 * 64; dst = wl + WL_CK2; N = 64; K = 256; Nd = 64; }
        else if (r < 10640) { r -= 10632; ja = A.in[23] + (size_t)l * 256 * 64; dst = wl + WL_CV2; N = 64; K = 256; Nd = 64; }
        else { r -= 10640; const int g = r >> 1; r &= 1; ja = A.in[25] + (size_t)l * 4 * 4096 + g * 4096; dst = wl + WL_PWT + g * 8192; N = 64; K = 64; Nd = 64; }
        tr_item(ja, jb_, gain, (bf16_t*)dst, N, mode, K, Nd, blocked, scr, r, lane);
    }
    { float* rt = (float*)(A.ws + WS_ROPE);
      for (int i = blockIdx.x * NTHR + tid; i < SEQ * 8; i += gridDim.x * NTHR) { const int t = i >> 3, k = i & 7; float sn, cs; sincosf((float)t * rope_inv(k), &sn, &cs); rt[t * 16 + k] = cs; rt[t * 16 + 8 + k] = sn; } }
    { const int gt = blockIdx.x * NTHR + tid, NGT = gridDim.x * NTHR;
      for (int i = gt; i < DEPTH * 4 * 128 * 128; i += NGT) { const int l = i >> 16, r = i & 65535, t = (r >> 7) & 127, s = r & 127;
          const float v = (s <= t) ? A.in[12][i] : 0.f; ((bf16_t*)(A.ws + WS_W + (size_t)l * WL_STRIDE + WL_GWS))[r] = (bf16_t)(pkbf(v, 0.f) & 0xffffu); }
    }
    { const float* x = A.in[0]; bf16_t* xb = (bf16_t*)(A.ws + WS_XB); float* ss = (float*)(A.ws + WS_SSP);
      for (int m = gw; m < MTOK; m += NGW) {
          const f32x4* xr = (const f32x4*)(x + (size_t)m * DM) + lane; f32x4 v[4]; float s = 0.f;
#pragma unroll
          for (int j = 0; j < 4; ++j) { v[j] = xr[64 * j]; s += (v[j][0] * v[j][0] + v[j][1] * v[j][1]) + (v[j][2] * v[j][2] + v[j][3] * v[j][3]); }
          s = wave_sum(s);
#pragma unroll
          for (int j = 0; j < 4; ++j) { u32x2 w; w.x = pkbf(v[j][0], v[j][1]); w.y = pkbf(v[j][2], v[j][3]); *(u32x2*)(xb + blk(m, 4 * lane + 256 * j, MTOK)) = w; }
          if (lane < 16) ss[(size_t)m * 16 + lane] = (lane == 0) ? s : 0.f;
      } }
}

struct LP {
    const bf16_t* P; const float* FFB; const float* ROPE; bf16_t *FQ, *FK, *FVT, *NQ, *NKS, *NVST, *NKW, *NVWT, *KCMP, *VCMPT, *O; float *FC, *NG;
    const float *fqn, *fkn, *nqn, *nkcn, *nksn, *nkwn, *fbias, *gbias, *gvn, *gbs, *posk, *posv, *pscale;
    const bf16_t *GWS, *PWT, *CK1, *CV1, *CK2, *CV2;
};
__device__ __forceinline__ LP make_lp(const Args& A, int l) {
    LP p; unsigned char* ws = A.ws; unsigned char* wl = ws + WS_W + (size_t)l * WL_STRIDE;
    p.P = (const bf16_t*)(ws + WS_R1); p.FFB = (const float*)(ws + WS_FFB); p.ROPE = (const float*)(ws + WS_ROPE); p.FQ = (bf16_t*)(ws + WS_FQ); p.FK = (bf16_t*)(ws + WS_FK); p.FVT = (bf16_t*)(ws + WS_FVT); p.NQ = (bf16_t*)(ws + WS_NQ);
    p.NKS = (bf16_t*)(ws + WS_NKS); p.NVST = (bf16_t*)(ws + WS_NVST); p.NKW = (bf16_t*)(ws + WS_NKW); p.NVWT = (bf16_t*)(ws + WS_NVWT);
    p.KCMP = (bf16_t*)(ws + WS_KCMP); p.VCMPT = (bf16_t*)(ws + WS_VCMPT); p.O = (bf16_t*)(ws + WS_O); p.FC = (float*)(ws + WS_FC); p.NG = (float*)(ws + WS_NG);
    p.fqn = A.in[9] + l * 64; p.fkn = A.in[10] + l * 64; p.nqn = A.in[14] + l * 64; p.nkcn = A.in[15] + l * 64; p.nksn = A.in[16] + l * 64; p.nkwn = A.in[17] + l * 64;
    p.fbias = A.in[8] + l * 4; p.gbias = A.in[24] + l * 12; p.gvn = A.in[11] + l * 256; p.gbs = A.in[13] + l * 512; p.posk = A.in[18] + l * 2048; p.posv = A.in[21] + l * 2048; p.pscale = A.in[26] + l * 256;
    p.GWS = (const bf16_t*)(wl + WL_GWS); p.PWT = (const bf16_t*)(wl + WL_PWT); p.CK1 = (const bf16_t*)(wl + WL_CK1); p.CV1 = (const bf16_t*)(wl + WL_CV1); p.CK2 = (const bf16_t*)(wl + WL_CK2); p.CV2 = (const bf16_t*)(wl + WL_CV2);
    return p;
}
constexpr int TT_CS = 0, TT_T = 4096, TT_TP = 784  , TT_Z = TT_T + 64 * TT_TP, TT_ZP = 528, TT_PL = TT_Z + 79 * TT_ZP, TT_END = TT_PL + 64 * TT_ZP;
static_assert(TT_END <= LDS_BYTES, "prep tile LDS");
__device__ __forceinline__ void prep_tile(const LP& p, int b, int t0, LAS unsigned char* lds) {
    const int tid = ltid(), lane = tid & 63, wave = tid >> 6;
    const size_t mb = (size_t)b * SEQ + t0;
    __syncthreads();
    { u32x4 sz[5];
#pragma unroll
      for (int i = 0; i < 5; ++i) { const int c = tid + i * NTHR, r = c >> 5, ch = c & 31; const int t = t0 - 15 + r; sz[i] = (u32x4){0u, 0u, 0u, 0u};
          if (c < 79 * 32 && t >= 0) sz[i] = *(const u32x4*)(p.P + ((size_t)b * SEQ + t) * NINP + C_PZ + 8 * ch); }
      SCHED_FENCE();
#pragma unroll
      for (int i = 0; i < 5; ++i) { const int c = tid + i * NTHR, r = c >> 5, ch = c & 31; if (c < 79 * 32) *(LAS u32x4*)(lds + TT_Z + r * TT_ZP + 16 * ch) = sz[i]; } }
    { const int tok = tid >> 3, sub = tid & 7; const int t = t0 + tok;
      u32x4 rawv[6];
#pragma unroll
      for (int v = 0; v < 6; ++v) { const int col = (v < 4) ? (C_FK + 64 * v) : (v == 4 ? C_NKS : C_NKW);
          rawv[v] = *(const u32x4*)(p.P + (mb + tok) * NINP + col + 8 * sub); }
      f32x4 gnv[3][2];
#pragma unroll
      for (int k = 0; k < 3; ++k) { const float* gp = (k == 0) ? p.fkn : (k == 1 ? p.nksn : p.nkwn); gnv[k][0] = *(const f32x4*)(gp + 8 * sub); gnv[k][1] = *(const f32x4*)(gp + 8 * sub + 4); }
      const float* rrow = p.ROPE + (size_t)t * 16;
      const f32x4 rc0 = *(const f32x4*)(rrow), rc1 = *(const f32x4*)(rrow + 4), rs0 = *(const f32x4*)(rrow + 8), rs1 = *(const f32x4*)(rrow + 12);
      SCHED_FENCE();
      float csn[8], ssn[8];
#pragma unroll
      for (int e = 0; e < 8; ++e) { csn[e] = (e < 4) ? rc0[e] : rc1[e - 4]; ssn[e] = (e < 4) ? rs0[e] : rs1[e - 4]; }
#pragma unroll
      for (int v = 0; v < 6; ++v) {
          bf16_t* dst; const bool rope = (v >= 4); const int gk = (v < 4) ? 0 : (v == 4 ? 1 : 2);
          if (v < 4) dst = p.FK + (((size_t)b * 4 + v) * SEQ + t) * 64;
          else if (v == 4) dst = p.NKS + ((size_t)b * SEQ + t) * 64;
          else dst = p.NKW + ((size_t)b * SEQ + t) * 64;
          const u32x4 raw = rawv[v];
          float x[8] = {bflo(raw.x), bfhi(raw.x), bflo(raw.y), bfhi(raw.y), bflo(raw.z), bfhi(raw.z), bflo(raw.w), bfhi(raw.w)};
          float sq = 0.f;
#pragma unroll
          for (int e = 0; e < 8; ++e) sq += x[e] * x[e];
          sq += __shfl_xor(sq, 1); sq += __shfl_xor(sq, 2); sq += __shfl_xor(sq, 4);
          const float rs = rsqrtf(sq * (1.0f / 64.0f) + EPS);
          const f32x4 g0 = gnv[gk][0], g1 = gnv[gk][1];
#pragma unroll
          for (int e = 0; e < 4; ++e) { x[e] = x[e] * rs * g0[e]; x[4 + e] = x[4 + e] * rs * g1[e]; }
          if (rope) {
#pragma unroll
              for (int e = 0; e < 8; ++e) { const float other = __shfl_xor(x[e], 1);
                  const float r0 = x[e] * csn[e] - other * ssn[e], r1 = x[e] * csn[e] + other * ssn[e];
                  x[e] = (sub == 0) ? r0 : ((sub == 1) ? r1 : x[e]); }
          }
          u32x4 w; w.x = pkbf(x[0], x[1]); w.y = pkbf(x[2], x[3]); w.z = pkbf(x[4], x[5]); w.w = pkbf(x[6], x[7]);
          *(u32x4*)(dst + 8 * sub) = w;
      } }
    for (int c = tid; c < 64 * 12; c += NTHR) { const int tok = c / 12, k = c - tok * 12;
        const float v = bflo((unsigned)p.P[(mb + tok) * NINP + C_NG + k]) + p.gbias[k]; p.NG[(mb + tok) * 12 + k] = 1.f / (1.f + __expf(-v)); }
    __syncthreads();
    { const int cp = tid & 127, seg = tid >> 7, g = cp >> 5, win = 2 << g;
      const LAS unsigned* z = (const LAS unsigned*)(lds + TT_Z) + cp;
      LAS unsigned* pl = (LAS unsigned*)(lds + TT_PL) + cp;
      const int tk0 = 16 * seg; float s0 = 0.f, s1 = 0.f;
      for (int k = 1; k < win; ++k) { const int t = t0 + tk0 - k; if (t >= 0) { const unsigned w = z[(15 + tk0 - k) * (TT_ZP / 4)]; s0 += bflo(w); s1 += bfhi(w); } }
#pragma unroll 4
      for (int tk = tk0; tk < tk0 + 16; ++tk) { const int t = t0 + tk; const unsigned w = z[(15 + tk) * (TT_ZP / 4)]; const float z0 = bflo(w), z1 = bfhi(w); s0 += z0; s1 += z1;
          const int cnt = (t + 1 < win) ? (t + 1) : win; const float inv = 1.0f / (float)cnt;
          pl[tk * (TT_ZP / 4)] = pkbf(s0 * inv - z0, s1 * inv - z1);
          if (t - win + 1 >= 0) { const unsigned wo = z[(15 + tk - win + 1) * (TT_ZP / 4)]; s0 -= bflo(wo); s1 -= bfhi(wo); } } }
    __syncthreads();
    { const int g = wave >> 1, mt0 = 2 * (wave & 1), l15 = lane & 15, l4 = lane >> 4;
      bf16x8 wa[4][2]; f32x4 scv[4];
#pragma unroll
      for (int et = 0; et < 4; ++et) { scv[et] = *(const f32x4*)(p.pscale + g * 64 + 16 * et + 4 * l4);
#pragma unroll
          for (int ks = 0; ks < 2; ++ks) wa[et][ks] = *(const bf16x8*)(p.PWT + g * 4096 + (16 * et + l15) * 64 + 32 * ks + 8 * l4); }
      SCHED_FENCE();
#pragma unroll
      for (int mi = 0; mi < 2; ++mi) { const int mt = mt0 + mi;
          bf16x8 bfr[2];
#pragma unroll
          for (int ks = 0; ks < 2; ++ks) bfr[ks] = *(const LAS bf16x8*)(lds + TT_PL + (16 * mt + l15) * TT_ZP + (g * 64 + 32 * ks + 8 * l4) * 2);
#pragma unroll
          for (int et = 0; et < 4; ++et) { f32x4 acc = {0.f, 0.f, 0.f, 0.f};
#pragma unroll
              for (int ks = 0; ks < 2; ++ks) acc = MFMA16(wa[et][ks], bfr[ks], acc);
              const int e0 = g * 64 + 16 * et + 4 * l4; const f32x4 sc = scv[et];
              u32x2 w; w.x = pkbf(acc[0] * sc[0], acc[1] * sc[1]); w.y = pkbf(acc[2] * sc[2], acc[3] * sc[3]);
              *(u32x2*)(p.O + blk(mb + 16 * mt + l15, 768 + e0, MTOK)) = w; } } }
}

__device__ __forceinline__ void prep_scan(const LP& p, int b, LAS unsigned char* lds) {
    const int tid = ltid(), lane = tid & 63, wave = tid >> 6;
    __syncthreads();
    float lf[4][4], tot[4] = {0.f, 0.f, 0.f, 0.f};
#pragma unroll
    for (int k = 0; k < 4; ++k) { const f32x4 fr4 = *(const f32x4*)(p.FFB + ((size_t)b * SEQ + 4 * tid + k) * 4);
        const float f[4] = {fr4[0], fr4[1], fr4[2], fr4[3]};
#pragma unroll
        for (int h = 0; h < 4; ++h) { const float x = f[h] + p.fbias[h]; const float v = -(fmaxf(-x, 0.f) + log1pf(expf(-fabsf(x)))); tot[h] += v; lf[k][h] = tot[h]; } }
    float pre[4];
#pragma unroll
    for (int h = 0; h < 4; ++h) { float v = tot[h];
#pragma unroll
        for (int o = 1; o < 64; o <<= 1) { const float u = __shfl_up(v, o); if (lane >= o) v += u; }
        pre[h] = v - tot[h];
        if (lane == 63) ((LAS float*)lds)[wave * 4 + h] = v; }
    __syncthreads();
#pragma unroll
    for (int h = 0; h < 4; ++h) { float base = 0.f; for (int w = 0; w < wave; ++w) base += ((const LAS float*)lds)[w * 4 + h];
#pragma unroll
        for (int k = 0; k < 4; ++k) p.FC[((size_t)b * 4 + h) * SEQ + 4 * tid + k] = (base + pre[h] + lf[k][h]) * LOG2E; }
}

constexpr int GM_VP = 272;
__device__ __forceinline__ void prep_gmlp(const LP& p, int b, int c, LAS unsigned char* lds) {
    const int tid = ltid(), lane = tid & 63, wave = tid >> 6;
    const size_t tb = (size_t)b * SEQ + 128 * c;
    __syncthreads();
    { const int tok = tid >> 2, g = tid & 3; float x[64]; float sq = 0.f;
#pragma unroll
      for (int k = 0; k < 8; ++k) { const u32x4 raw = *(const u32x4*)(p.P + (tb + tok) * NINP + C_GV + 64 * g + 8 * k);
          const float f[8] = {bflo(raw.x), bfhi(raw.x), bflo(raw.y), bfhi(raw.y), bflo(raw.z), bfhi(raw.z), bflo(raw.w), bfhi(raw.w)};
#pragma unroll
          for (int e = 0; e < 8; ++e) { const float v = gelu_t(f[e]); x[8 * k + e] = v; sq += v * v; } }
      const float rs = rsqrtf(sq * (1.0f / 64.0f) + EPS);
#pragma unroll
      for (int d = 0; d < 64; ++d) { const float v = x[d] * rs * p.gvn[64 * g + d]; ((LAS bf16_t*)(lds + (64 * g + d) * GM_VP))[tok] = (bf16_t)(pkbf(v, 0.f) & 0xffffu); } }
    __syncthreads();
    { const int g = wave >> 1, l15 = lane & 15, l4 = lane >> 4;
#pragma unroll 2
      for (int ti = 0; ti < 4; ++ti) { const int tt = 4 * (wave & 1) + ti; const int t = 16 * tt + l15;
          f32x4 acc[4];
#pragma unroll
          for (int dt = 0; dt < 4; ++dt) acc[dt] = (f32x4){0.f, 0.f, 0.f, 0.f};
          bf16x8 bwv[4];
#pragma unroll
          for (int ks = 0; ks < 4; ++ks) bwv[ks] = *(const bf16x8*)(p.GWS + ((size_t)g * 128 + t) * 128 + 32 * ks + 8 * l4);
          u32x2 urv[4];
#pragma unroll
          for (int dt = 0; dt < 4; ++dt) urv[dt] = *(const u32x2*)(p.P + (tb + t) * NINP + C_GU + 64 * g + 16 * dt + 4 * l4);
          const float bs = p.gbs[g * 128 + t];
          SCHED_FENCE();
#pragma unroll
          for (int ks = 0; ks < 4; ++ks) { if (ks <= (tt >> 1)) {
#pragma unroll
              for (int dt = 0; dt < 4; ++dt) { const bf16x8 a = *(const LAS bf16x8*)(lds + (64 * g + 16 * dt + l15) * GM_VP + (32 * ks + 8 * l4) * 2); acc[dt] = MFMA16(a, bwv[ks], acc[dt]); } } }
#pragma unroll
          for (int dt = 0; dt < 4; ++dt) { const int d0 = 64 * g + 16 * dt + 4 * l4;
              const u32x2 ur = urv[dt];
              const float u0 = gelu_t(bflo(ur.x)), u1 = gelu_t(bfhi(ur.x)), u2 = gelu_t(bflo(ur.y)), u3 = gelu_t(bfhi(ur.y));
              u32x2 w; w.x = pkbf(u0 * (acc[dt][0] + bs), u1 * (acc[dt][1] + bs)); w.y = pkbf(u2 * (acc[dt][2] + bs), u3 * (acc[dt][3] + bs));
              *(u32x2*)(p.O + blk(tb + t, 256 + d0, MTOK)) = w; } } }
}

constexpr int CM_HP = 528;
__device__ __forceinline__ void prep_cmp(const LP& p, int which, int b, int ng, LAS unsigned char* lds) {
    const int tid = ltid(), lane = tid & 63, wave = tid >> 6, l15 = lane & 15, l4 = lane >> 4;
    const bf16_t* W1 = which ? p.CV1 : p.CK1; const bf16_t* W2 = which ? p.CV2 : p.CK2; const float* pos = which ? p.posv : p.posk; const int ccol = which ? C_NVC : C_NKC;
    __syncthreads();
    { int n0 = 32 * ng + l15, n1 = n0 + 16; if (n0 > 126) n0 = 126; if (n1 > 126) n1 = 126;
      const bf16_t* ar0 = p.P + ((size_t)b * SEQ + 16 * n0) * NINP + ccol; const bf16_t* ar1 = p.P + ((size_t)b * SEQ + 16 * n1) * NINP + ccol;
      f32x4 acc[2][2];
#pragma unroll
      for (int i = 0; i < 2; ++i)
#pragma unroll
          for (int k = 0; k < 2; ++k) acc[i][k] = (f32x4){0.f, 0.f, 0.f, 0.f};
      const bf16_t* w0 = W1 + (size_t)(32 * wave + l15) * 2048 + 8 * l4; const bf16_t* w1 = w0 + 16 * 2048;
#pragma unroll 1
      for (int kb = 0; kb < 16; ++kb) {
          u32x4 ra[2][4]; f32x4 pp[4][2]; bf16x8 bb[2][4];
#pragma unroll
          for (int q = 0; q < 4; ++q) { const int ks = 4 * kb + q, tt = ks >> 1, d0 = 32 * (ks & 1) + 8 * l4;
              ra[0][q] = *(const u32x4*)(ar0 + (size_t)tt * NINP + d0); ra[1][q] = *(const u32x4*)(ar1 + (size_t)tt * NINP + d0);
              pp[q][0] = *(const f32x4*)(pos + tt * 64 + d0); pp[q][1] = *(const f32x4*)(pos + tt * 64 + d0 + 4);
              bb[0][q] = *(const bf16x8*)(w0 + 32 * ks); bb[1][q] = *(const bf16x8*)(w1 + 32 * ks); }
          SCHED_FENCE();
#pragma unroll
          for (int q = 0; q < 4; ++q)
#pragma unroll
              for (int i = 0; i < 2; ++i) { const u32x4 raw = ra[i][q]; const f32x4 p0 = pp[q][0], p1 = pp[q][1];
                  u32x4 aw; aw.x = pkbf(bflo(raw.x) + p0[0], bfhi(raw.x) + p0[1]); aw.y = pkbf(bflo(raw.y) + p0[2], bfhi(raw.y) + p0[3]);
                  aw.z = pkbf(bflo(raw.z) + p1[0], bfhi(raw.z) + p1[1]); aw.w = pkbf(bflo(raw.w) + p1[2], bfhi(raw.w) + p1[3]);
                  const bf16x8 a = __builtin_bit_cast(bf16x8, aw);
                  acc[i][0] = MFMA16(a, bb[0][q], acc[i][0]); acc[i][1] = MFMA16(a, bb[1][q], acc[i][1]); }
          SCHED_FENCE();
      }
#pragma unroll
      for (int i = 0; i < 2; ++i)
#pragma unroll
          for (int e = 0; e < 4; ++e) { LAS bf16_t* hr = (LAS bf16_t*)(lds + (16 * i + 4 * l4 + e) * CM_HP);
              hr[32 * wave + l15] = (bf16_t)(pkbf(gelu_t(acc[i][0][e]), 0.f) & 0xffffu); hr[32 * wave + 16 + l15] = (bf16_t)(pkbf(gelu_t(acc[i][1][e]), 0.f) & 0xffffu); } }
    __syncthreads();
    LAS float* outl = (LAS float*)(lds + 32 * CM_HP);
    { const int mt = wave >> 2, ct = wave & 3; f32x4 acc = {0.f, 0.f, 0.f, 0.f}; bf16x8 bw[8];
#pragma unroll
      for (int ks = 0; ks < 8; ++ks) bw[ks] = *(const bf16x8*)(W2 + (size_t)(16 * ct + l15) * 256 + 32 * ks + 8 * l4);
      SCHED_FENCE();
#pragma unroll
      for (int ks = 0; ks < 8; ++ks) { const bf16x8 a = *(const LAS bf16x8*)(lds + (16 * mt + l15) * CM_HP + (32 * ks + 8 * l4) * 2); acc = MFMA16(a, bw[ks], acc); }
#pragma unroll
      for (int e = 0; e < 4; ++e) outl[(16 * mt + 4 * l4 + e) * 65 + 16 * ct + l15] = acc[e]; }
    __syncthreads();
    if (which == 0) {
        if (tid < 256) { const int row = tid >> 3, sub = tid & 7, n = 32 * ng + row; float x[8]; float sq = 0.f;
#pragma unroll
            for (int e = 0; e < 8; ++e) { x[e] = outl[row * 65 + 8 * sub + e]; sq += x[e] * x[e]; }
            sq += __shfl_xor(sq, 1); sq += __shfl_xor(sq, 2); sq += __shfl_xor(sq, 4);
            const float rs = rsqrtf(sq * (1.0f / 64.0f) + EPS);
#pragma unroll
            for (int e = 0; e < 8; ++e) x[e] = x[e] * rs * p.nkcn[8 * sub + e];
            const float* rrow = p.ROPE + (size_t)((n < 127) ? (16 * n + 31) : 0) * 16;
#pragma unroll
            for (int e = 0; e < 8; ++e) { const float other = __shfl_xor(x[e], 1); const float cs = rrow[e], sn = rrow[8 + e];
                const float r0 = x[e] * cs - other * sn, r1 = x[e] * cs + other * sn; x[e] = (sub == 0) ? r0 : ((sub == 1) ? r1 : x[e]); }
            u32x4 w; w.x = pkbf(x[0], x[1]); w.y = pkbf(x[2], x[3]); w.z = pkbf(x[4], x[5]); w.w = pkbf(x[6], x[7]);
            if (n >= 127) w = (u32x4){0u, 0u, 0u, 0u};
            *(u32x4*)(p.KCMP + ((size_t)b * 128 + n) * 64 + 8 * sub) = w; }
    } else {
        for (int c2 = tid; c2 < 2048; c2 += NTHR) { const int d = c2 >> 5, row = c2 & 31, n = 32 * ng + row;
            const float v = (n < 127) ? outl[row * 65 + d] : 0.f; p.VCMPT[((size_t)b * 64 + d) * 128 + n] = (bf16_t)(pkbf(v, 0.f) & 0xffffu); }
    }
}

constexpr int AT_KOFF = 0, AT_VOFF = 9216, AT_COFF = 18432, AT_BUF = 18688, AT_P = 144;
typedef short v4i16_t __attribute__((ext_vector_type(4)));
__device__ __forceinline__ s16x4 vtr(const LAS unsigned char* p) { return __builtin_bit_cast(s16x4, __builtin_amdgcn_ds_read_tr16_b64_v4i16((LAS v4i16_t*)p)); }
template <int MODE>
__device__ __forceinline__ void attn_tile(const LAS unsigned char* buf, const int j, const bf16x8 (&qf)[4], const int qpos, const unsigned selm, const int wq_lo, const int r32, const int h,
                                          float& m, float& lsum, f32x16 (&o)[2]) {
    const int key0 = 64 * j;
    bool active = key0 <= wq_lo + 31; if (MODE == 2) active = active && (key0 + 63 + 512 > wq_lo);
    const bool selok = (MODE != 1) || (((selm >> j) & 1u) != 0u);
    if (MODE == 1) active = active && (__builtin_amdgcn_ballot_w64(selok) != 0ull);
    if (!active) return;
    f32x16 s[2];
#pragma unroll
    for (int i = 0; i < 16; ++i) { s[0][i] = 0.f; s[1][i] = 0.f; }
    { bf16x8 ka[2][4];
#pragma unroll
      for (int st = 0; st < 4; ++st) { ka[0][st] = *(const LAS bf16x8*)(buf + AT_KOFF + r32 * AT_P + 32 * st + 16 * h); ka[1][st] = *(const LAS bf16x8*)(buf + AT_KOFF + (32 + r32) * AT_P + 32 * st + 16 * h); }
      __builtin_amdgcn_s_setprio(1);
#pragma unroll
      for (int st = 0; st < 4; ++st) { s[0] = MFMA32(ka[0][st], qf[st], s[0]); s[1] = MFMA32(ka[1][st], qf[st], s[1]); }
      __builtin_amdgcn_s_setprio(0); }
    const bool interior = (key0 + 63 <= wq_lo) && (MODE != 2 || (key0 + 512 > wq_lo + 31));
    float mx = -1e30f, csub;
    if (interior) {
#pragma unroll
        for (int kt = 0; kt < 2; ++kt)
#pragma unroll
            for (int g = 0; g < 4; ++g) {
                if (MODE == 0) { const f32x4 cv = *(const LAS f32x4*)(buf + AT_COFF + (32 * kt + 8 * g + 4 * h) * 4);
#pragma unroll
                    for (int e = 0; e < 4; ++e) s[kt][4 * g + e] -= cv[e]; }
                mx = fmaxf(mx, fmaxf(fmaxf(s[kt][4 * g], s[kt][4 * g + 1]), fmaxf(s[kt][4 * g + 2], s[kt][4 * g + 3]))); }
        mx = x32_max(mx);
        if (MODE == 1) mx = selok ? mx : -1e30f;
    } else {
#pragma unroll
        for (int kt = 0; kt < 2; ++kt)
#pragma unroll
            for (int g = 0; g < 4; ++g) {
                f32x4 cv = {0.f, 0.f, 0.f, 0.f}; if (MODE == 0) cv = *(const LAS f32x4*)(buf + AT_COFF + (32 * kt + 8 * g + 4 * h) * 4);
#pragma unroll
                for (int e = 0; e < 4; ++e) { const int key = key0 + 32 * kt + 8 * g + 4 * h + e; float v = s[kt][4 * g + e];
                    if (MODE == 0) v -= cv[e];
                    bool ok = (key <= qpos) && selok; if (MODE == 2) ok = ok && (key + 512 > qpos);
                    v = ok ? v : -3e38f; s[kt][4 * g + e] = v; mx = fmaxf(mx, v); } }
        mx = x32_max(mx);
        mx = fmaxf(mx, -1e30f);
    }
    const bool resc = __builtin_amdgcn_ballot_w64(mx > m + 8.0f) != 0ull;
    const float mn = resc ? fmaxf(m, mx) : m, alpha = resc ? __builtin_amdgcn_exp2f(m - mn) : 1.0f;
    csub = (mn > -1e29f) ? mn : 0.f;
    if (MODE == 1 && interior && !selok) csub = 3e38f;
    m = mn;
    s16x4 vlo[2][2][2], vhi[2][2][2];
#pragma unroll
    for (int kt = 0; kt < 2; ++kt)
#pragma unroll
        for (int s2 = 0; s2 < 2; ++s2)
#pragma unroll
            for (int dt = 0; dt < 2; ++dt) {
                const LAS unsigned char* vp = buf + AT_VOFF + (32 * kt + 16 * s2 + 4 * h + ((r32 & 15) >> 2)) * AT_P + (32 * dt + (r32 & 16) + 4 * (r32 & 3)) * 2;
                vlo[kt][s2][dt] = vtr(vp); vhi[kt][s2][dt] = vtr(vp + 8 * AT_P); }
    typedef float f32x2p __attribute__((ext_vector_type(2)));
    f32x2p ps2 = {0.f, 0.f}; const f32x2p cs2 = {csub, csub};
#pragma unroll
    for (int kt = 0; kt < 2; ++kt)
#pragma unroll
        for (int i = 0; i < 8; ++i) { f32x2p d = {s[kt][2 * i], s[kt][2 * i + 1]}; d = d - cs2; d.x = __builtin_amdgcn_exp2f(d.x); d.y = __builtin_amdgcn_exp2f(d.y); s[kt][2 * i] = d.x; s[kt][2 * i + 1] = d.y; ps2 += d; }
    lsum = lsum * alpha + (ps2.x + ps2.y);
    if (resc) {
#pragma unroll
        for (int i = 0; i < 16; ++i) { o[0][i] *= alpha; o[1][i] *= alpha; } }
#pragma unroll
    for (int kt = 0; kt < 2; ++kt)
#pragma unroll
        for (int s2 = 0; s2 < 2; ++s2) {
            u32x4 pw; pw.x = pkbf(s[kt][8 * s2 + 0], s[kt][8 * s2 + 1]); pw.y = pkbf(s[kt][8 * s2 + 2], s[kt][8 * s2 + 3]); pw.z = pkbf(s[kt][8 * s2 + 4], s[kt][8 * s2 + 5]); pw.w = pkbf(s[kt][8 * s2 + 6], s[kt][8 * s2 + 7]);
            const bf16x8 pb = __builtin_bit_cast(bf16x8, pw);
#pragma unroll
            for (int dt = 0; dt < 2; ++dt) { const bf16x8 a = __builtin_shufflevector(vlo[kt][s2][dt], vhi[kt][s2][dt], 0, 1, 2, 3, 4, 5, 6, 7); o[dt] = MFMA32(a, pb, o[dt]); } }
}
template <int MODE>
__device__ __forceinline__ void attn_run(LAS unsigned char* lds, const bf16_t* __restrict__ Kb, const bf16_t* __restrict__ Vb, const int vpitch, const float* __restrict__ Cb, unsigned tmask,
                                         const bf16x8 (&qf)[4], int qpos, float cq, unsigned selm, int wq_lo, f32x16 (&o)[2]) {
    const int tid = ltid(), lane = tid & 63, r32 = lane & 31, h = lane >> 5, lr = tid >> 3, lc = tid & 7;
#pragma unroll
    for (int i = 0; i < 16; ++i) { o[0][i] = 0.f; o[1][i] = 0.f; }
    float m = -1e30f, lsum = 0.f;
    __syncthreads();
    int ja = __builtin_ctz(tmask); tmask &= tmask - 1;
    int jb = -1; if (tmask) { jb = __builtin_ctz(tmask); tmask &= tmask - 1; }
    { const u32x4 kr = *(const u32x4*)(Kb + (size_t)(64 * ja + lr) * 64 + 8 * lc); const u32x4 vr = *(const u32x4*)(Vb + (size_t)(64 * ja + lr) * vpitch + 8 * lc);
      *(LAS u32x4*)(lds + AT_KOFF + lr * AT_P + 16 * lc) = kr; *(LAS u32x4*)(lds + AT_VOFF + lr * AT_P + 16 * lc) = vr;
      if (MODE == 0 && tid < 64) *(LAS float*)(lds + AT_COFF + 4 * tid) = Cb[64 * ja + tid];
      if (jb >= 0) { const u32x4 kr2 = *(const u32x4*)(Kb + (size_t)(64 * jb + lr) * 64 + 8 * lc); const u32x4 vr2 = *(const u32x4*)(Vb + (size_t)(64 * jb + lr) * vpitch + 8 * lc);
          *(LAS u32x4*)(lds + AT_BUF + AT_KOFF + lr * AT_P + 16 * lc) = kr2; *(LAS u32x4*)(lds + AT_BUF + AT_VOFF + lr * AT_P + 16 * lc) = vr2;
          if (MODE == 0 && tid < 64) *(LAS float*)(lds + AT_BUF + AT_COFF + 4 * tid) = Cb[64 * jb + tid]; } }
    __syncthreads();
    int cur = 0;
    for (;;) {
        const bool more = tmask != 0u; int na = 0, nb = -1; u32x4 kr = {0u, 0u, 0u, 0u}, vr = {0u, 0u, 0u, 0u}, kr2 = {0u, 0u, 0u, 0u}, vr2 = {0u, 0u, 0u, 0u}; float cr = 0.f, cr2 = 0.f;
        if (more) { na = __builtin_ctz(tmask); tmask &= tmask - 1; if (tmask) { nb = __builtin_ctz(tmask); tmask &= tmask - 1; }
            kr = *(const u32x4*)(Kb + (size_t)(64 * na + lr) * 64 + 8 * lc); vr = *(const u32x4*)(Vb + (size_t)(64 * na + lr) * vpitch + 8 * lc);
            if (MODE == 0 && tid < 64) cr = Cb[64 * na + tid];
            if (nb >= 0) { kr2 = *(const u32x4*)(Kb + (size_t)(64 * nb + lr) * 64 + 8 * lc); vr2 = *(const u32x4*)(Vb + (size_t)(64 * nb + lr) * vpitch + 8 * lc);
                if (MODE == 0 && tid < 64) cr2 = Cb[64 * nb + tid]; } }
        const LAS unsigned char* buf = lds + cur * (2 * AT_BUF);
        { attn_tile<MODE>(buf, ja, qf, qpos, selm, wq_lo, r32, h, m, lsum, o);
               if (jb >= 0) attn_tile<MODE>(buf + AT_BUF, jb, qf, qpos, selm, wq_lo, r32, h, m, lsum, o); }
        if (more) { LAS unsigned char* nbuf = lds + (cur ^ 1) * (2 * AT_BUF);
            *(LAS u32x4*)(nbuf + AT_KOFF + lr * AT_P + 16 * lc) = kr; *(LAS u32x4*)(nbuf + AT_VOFF + lr * AT_P + 16 * lc) = vr;
            if (MODE == 0 && tid < 64) *(LAS float*)(nbuf + AT_COFF + 4 * tid) = cr;
            if (nb >= 0) { *(LAS u32x4*)(nbuf + AT_BUF + AT_KOFF + lr * AT_P + 16 * lc) = kr2; *(LAS u32x4*)(nbuf + AT_BUF + AT_VOFF + lr * AT_P + 16 * lc) = vr2;
                if (MODE == 0 && tid < 64) *(LAS float*)(nbuf + AT_BUF + AT_COFF + 4 * tid) = cr2; } }
        __syncthreads();
        if (!more) break;
        ja = na; jb = nb; cur ^= 1;
    }
    const float lt = x32_sum(lsum); const float inv = (lt > 0.f) ? 1.0f / lt : 0.f;
#pragma unroll
    for (int i = 0; i < 16; ++i) { o[0][i] *= inv; o[1][i] *= inv; }
}
__device__ __forceinline__ void store_ot(bf16_t* orow, const f32x16 (&o)[2], int h) {
#pragma unroll
    for (int dt = 0; dt < 2; ++dt)
#pragma unroll
        for (int g = 0; g < 4; ++g) { u32x2 w; w.x = pkbf(o[dt][4 * g], o[dt][4 * g + 1]); w.y = pkbf(o[dt][4 * g + 2], o[dt][4 * g + 3]); *(u32x2*)(orow + 32 * dt + 8 * g + 4 * h) = w; }
}

template <bool ROPED>
__device__ __forceinline__ void load_q(const bf16_t* __restrict__ qrow, const float* __restrict__ gn, const float* __restrict__ ropet, const int h, bf16x8 (&qf)[4]) {
    u32x4 raw[4]; f32x4 g[4][2]; f32x4 cs[2], sn[2];
#pragma unroll
    for (int st = 0; st < 4; ++st) { raw[st] = *(const u32x4*)(qrow + 16 * st + 8 * h); g[st][0] = *(const f32x4*)(gn + 16 * st + 8 * h); g[st][1] = *(const f32x4*)(gn + 16 * st + 8 * h + 4); }
    if (ROPED) { cs[0] = *(const f32x4*)(ropet); cs[1] = *(const f32x4*)(ropet + 4); sn[0] = *(const f32x4*)(ropet + 8); sn[1] = *(const f32x4*)(ropet + 12); }
    float x[4][8]; float sq = 0.f;
#pragma unroll
    for (int st = 0; st < 4; ++st) { const u32x4 r = raw[st]; x[st][0] = bflo(r.x); x[st][1] = bfhi(r.x); x[st][2] = bflo(r.y); x[st][3] = bfhi(r.y); x[st][4] = bflo(r.z); x[st][5] = bfhi(r.z); x[st][6] = bflo(r.w); x[st][7] = bfhi(r.w);
#pragma unroll
        for (int e = 0; e < 8; ++e) sq += x[st][e] * x[st][e]; }
    sq = x32_sum(sq);
    const float rs = rsqrtf(sq * (1.0f / 64.0f) + EPS);
#pragma unroll
    for (int st = 0; st < 4; ++st)
#pragma unroll
        for (int e = 0; e < 4; ++e) { x[st][e] = x[st][e] * rs * g[st][0][e]; x[st][4 + e] = x[st][4 + e] * rs * g[st][1][e]; }
    if (ROPED) {
#pragma unroll
        for (int e = 0; e < 8; ++e) { auto t = __builtin_amdgcn_permlane32_swap(__float_as_uint(x[0][e]), __float_as_uint(x[0][e]), false, false);
            const float other = h ? __uint_as_float(t[0]) : __uint_as_float(t[1]);
            const float c1 = cs[e >> 2][e & 3], s1 = sn[e >> 2][e & 3];
            x[0][e] = h ? (x[0][e] * c1 + other * s1) : (x[0][e] * c1 - other * s1); } }
#pragma unroll
    for (int st = 0; st < 4; ++st) { u32x4 w; w.x = pkbf(x[st][0] * QSCALE, x[st][1] * QSCALE); w.y = pkbf(x[st][2] * QSCALE, x[st][3] * QSCALE); w.z = pkbf(x[st][4] * QSCALE, x[st][5] * QSCALE); w.w = pkbf(x[st][6] * QSCALE, x[st][7] * QSCALE);
        qf[st] = __builtin_bit_cast(bf16x8, w); }
}
__device__ __forceinline__ void fox_unit(const LP& p, int bh, int qb, LAS unsigned char* lds) {
    const int tid = ltid(), lane = tid & 63, wave = __builtin_amdgcn_readfirstlane(tid >> 6), r32 = lane & 31, h = lane >> 5;
    const int q0w = 256 * qb + 32 * wave, qpos = q0w + r32;
    bf16x8 qf[4];
    load_q<false>(p.P + ((size_t)(bh >> 2) * SEQ + qpos) * NINP + C_FQ + (bh & 3) * 64, p.fqn, nullptr, h, qf);
    const float cq = 0.f;
    const int nt = 4 * (qb + 1);
    const float c_first = p.FC[(size_t)bh * SEQ + 256 * qb];
    const float c_tile = (lane < nt) ? p.FC[(size_t)bh * SEQ + 64 * lane + 63] : 0.f;
    const unsigned tmask = (unsigned)__builtin_amdgcn_ballot_w64((lane < nt) && (c_first - c_tile >= -70.0f));
    f32x16 o[2];
    attn_run<0>(lds, p.FK + (size_t)bh * SEQ * 64, p.P + (size_t)(bh >> 2) * SEQ * NINP + C_FV + (bh & 3) * 64, NINP, p.FC + (size_t)bh * SEQ, tmask, qf, qpos, cq, 0u, q0w, o);
    const int b = bh >> 2, hh = bh & 3;
    int qq = qpos, hq = h; asm volatile("" : "+v"(qq), "+v"(hq));
    store_ot(p.O + blk((size_t)b * SEQ + qq, hh * 64, MTOK), o, hq);
}

constexpr int NS_IA = 0, NS_IB = NS_IA + 4 * 64 * 33 * 4, NS_IF = NS_IB + 4 * 64 * 33 * 4, NS_KC = NS_IF + 64 * 33 * 4, NS_KCP = 144, NS_VC = NS_KC + 128 * NS_KCP, NS_VCP = 272, NS_SEL = NS_VC + 64 * NS_VCP, NS_UM = NS_SEL + 256, NS_END = NS_UM + 16;
static_assert(4 * AT_BUF <= NS_KC, "attention buffers alias only the importance tables");
static_assert(NS_END <= LDS_BYTES, "nsa LDS");
__device__ __forceinline__ void nsa_unit(const LP& p, int b, int qblk, LAS unsigned char* lds) {
    const int tid = ltid(), lane = tid & 63, wave = __builtin_amdgcn_readfirstlane(tid >> 6), r32 = lane & 31, h = lane >> 5;
    const int hd = wave >> 1, qh = wave & 1, t0 = 64 * qblk, ql = 32 * qh + r32, qpos = t0 + ql, q0w = t0 + 32 * qh, cur = qblk;
    const size_t mrow = (size_t)b * SEQ + qpos;
    bf16x8 qf[4];
    load_q<true>(p.P + mrow * NINP + C_NQ + hd * 64, p.nqn, p.ROPE + (size_t)qpos * 16, h, qf);
    const float g0 = p.NG[mrow * 12 + hd * 3 + 0], g1 = p.NG[mrow * 12 + hd * 3 + 1], g2 = p.NG[mrow * 12 + hd * 3 + 2];
    { u32x4 kc0 = *(const u32x4*)(p.KCMP + ((size_t)b * 128 + (tid >> 3)) * 64 + 8 * (tid & 7)), kc1 = *(const u32x4*)(p.KCMP + ((size_t)b * 128 + 64 + (tid >> 3)) * 64 + 8 * (tid & 7));
      u32x4 vc0 = *(const u32x4*)(p.VCMPT + ((size_t)b * 64 + (tid >> 4)) * 128 + 8 * (tid & 15)), vc1 = *(const u32x4*)(p.VCMPT + ((size_t)b * 64 + 32 + (tid >> 4)) * 128 + 8 * (tid & 15));
      SCHED_FENCE();
      __syncthreads();
      *(LAS u32x4*)(lds + NS_KC + (tid >> 3) * NS_KCP + 16 * (tid & 7)) = kc0; *(LAS u32x4*)(lds + NS_KC + (64 + (tid >> 3)) * NS_KCP + 16 * (tid & 7)) = kc1;
      *(LAS u32x4*)(lds + NS_VC + (tid >> 4) * NS_VCP + 16 * (tid & 15)) = vc0; *(LAS u32x4*)(lds + NS_VC + (32 + (tid >> 4)) * NS_VCP + 16 * (tid & 15)) = vc1; }
    if (tid < 64) ((LAS unsigned*)(lds + NS_SEL))[tid] = 0u;
    if (tid == 64) ((LAS unsigned*)(lds + NS_UM))[0] = 0u;
    __syncthreads();
    f32x16 out[2];
    {
      f32x16 s[4];
#pragma unroll
      for (int nt = 0; nt < 4; ++nt) {
#pragma unroll
          for (int i = 0; i < 16; ++i) s[nt][i] = 0.f;
#pragma unroll
          for (int st = 0; st < 4; ++st) { const bf16x8 a = *(const LAS bf16x8*)(lds + NS_KC + (32 * nt + r32) * NS_KCP + 32 * st + 16 * h); s[nt] = MFMA32(a, qf[st], s[nt]); } }
      float mx = -1e30f;
#pragma unroll
      for (int nt = 0; nt < 4; ++nt)
#pragma unroll
          for (int i = 0; i < 16; ++i) { const int n = 32 * nt + (i & 3) + 8 * (i >> 2) + 4 * h; const bool ok = (n < 127) && (16 * n + 31 <= qpos); const float v = ok ? s[nt][i] : -1e30f; s[nt][i] = v; mx = fmaxf(mx, v); }
      mx = x32_max(mx);
      float ps = 0.f;
#pragma unroll
      for (int nt = 0; nt < 4; ++nt)
#pragma unroll
          for (int i = 0; i < 16; ++i) { const float v = s[nt][i]; const float pe = (v > -1e29f) ? __builtin_amdgcn_exp2f(v - mx) : 0.f; s[nt][i] = pe; ps += pe; }
      ps = x32_sum(ps);
      const float inv = (ps > 0.f) ? 1.0f / ps : 0.f;
      LAS float* ia = (LAS float*)(lds + NS_IA) + (hd * 64 + ql) * 33; LAS float* ib = (LAS float*)(lds + NS_IB) + (hd * 64 + ql) * 33;
#pragma unroll
      for (int nt = 0; nt < 4; ++nt) {
#pragma unroll
          for (int i = 0; i < 16; ++i) s[nt][i] *= inv;
          if (cur >= 16) {
#pragma unroll
          for (int g = 0; g < 4; ++g) { const int jb = 8 * nt + 2 * g + h; ia[jb] = (s[nt][4 * g] + s[nt][4 * g + 1]) + s[nt][4 * g + 2] + 0.5f * s[nt][4 * g + 3]; ib[jb] = 0.5f * s[nt][4 * g + 3]; } } }
      f32x16 oc[2];
#pragma unroll
      for (int i = 0; i < 16; ++i) { oc[0][i] = 0.f; oc[1][i] = 0.f; }
#pragma unroll
      for (int nt = 0; nt < 4; ++nt)
#pragma unroll
          for (int s2 = 0; s2 < 2; ++s2) {
              u32x4 pw; pw.x = pkbf(s[nt][8 * s2 + 0], s[nt][8 * s2 + 1]); pw.y = pkbf(s[nt][8 * s2 + 2], s[nt][8 * s2 + 3]); pw.z = pkbf(s[nt][8 * s2 + 4], s[nt][8 * s2 + 5]); pw.w = pkbf(s[nt][8 * s2 + 6], s[nt][8 * s2 + 7]);
              const bf16x8 pb = __builtin_bit_cast(bf16x8, pw);
#pragma unroll
              for (int dt = 0; dt < 2; ++dt) { const LAS unsigned char* vp = lds + NS_VC + (32 * dt + r32) * NS_VCP + (32 * nt + 16 * s2 + 4 * h) * 2;
                  const s16x4 lo = *(const LAS s16x4*)vp, hi = *(const LAS s16x4*)(vp + 16);
                  const bf16x8 a = __builtin_shufflevector(lo, hi, 0, 1, 2, 3, 4, 5, 6, 7); oc[dt] = MFMA32(a, pb, oc[dt]); } }
#pragma unroll
      for (int i = 0; i < 16; ++i) { out[0][i] = g0 * oc[0][i]; out[1][i] = g0 * oc[1][i]; }
    }
    __syncthreads();
    if (cur < 16) {
        const unsigned allm = (1u << (cur + 1)) - 1u;
        if (tid < 64) ((LAS unsigned*)(lds + NS_SEL))[tid] = allm;
        if (tid == 64) ((LAS unsigned*)(lds + NS_UM))[0] = allm;
        __syncthreads();
    } else {
    LAS float* impf = (LAS float*)(lds + NS_IF);
    { const int q = tid & 63, jg = tid >> 6;
#pragma unroll
      for (int k = 0; k < 4; ++k) { const int jb = 4 * jg + k; float v = 0.f;
#pragma unroll
          for (int hh = 0; hh < 4; ++hh) { v += ((const LAS float*)(lds + NS_IA))[(hh * 64 + q) * 33 + jb]; if (jb > 0) v += ((const LAS float*)(lds + NS_IB))[(hh * 64 + q) * 33 + jb - 1]; }
          const bool forced = (jb == 0) || (jb == cur) || (jb == cur - 1);
          v = (jb <= cur) ? (v + (forced ? 1000.0f : 0.f)) : -1e30f;
          impf[q * 33 + jb] = v; } }
    __syncthreads();
    { const int q = tid & 63, jg = tid >> 6; unsigned bits = 0u;
      float mine[4];
#pragma unroll
      for (int k = 0; k < 4; ++k) mine[k] = impf[q * 33 + 4 * jg + k];
      int cnt[4] = {0, 0, 0, 0};
      for (int i = 0; i < 32; ++i) { const float vi = impf[q * 33 + i];
#pragma unroll
          for (int k = 0; k < 4; ++k) { const int jb = 4 * jg + k; cnt[k] += ((vi > mine[k]) || (vi == mine[k] && i < jb)) ? 1 : 0; } }
#pragma unroll
      for (int k = 0; k < 4; ++k) if (cnt[k] < 16 && mine[k] > -5e29f) bits |= 1u << (4 * jg + k);
      if (bits) { atomicOr((unsigned*)(lds + NS_SEL) + q, bits); atomicOr((unsigned*)(lds + NS_UM), bits); } }
    __syncthreads();
    }
    const unsigned selm = ((const LAS unsigned*)(lds + NS_SEL))[ql];
    const unsigned um = __builtin_amdgcn_readfirstlane(((const LAS unsigned*)(lds + NS_UM))[0]);
    f32x16 o[2];
    attn_run<1>(lds, p.NKS + (size_t)b * SEQ * 64, p.P + (size_t)b * SEQ * NINP + C_NVS, NINP, nullptr, um, qf, qpos, 0.f, selm, q0w, o);
#pragma unroll
    for (int i = 0; i < 16; ++i) { out[0][i] += g1 * o[0][i]; out[1][i] += g1 * o[1][i]; }
    { const int lo = (cur >= 8) ? (cur - 8) : 0; const unsigned hi_m = (cur >= 31) ? 0xffffffffu : ((1u << (cur + 1)) - 1u); const unsigned wm = hi_m & ~((1u << lo) - 1u);
      attn_run<2>(lds, p.NKW + (size_t)b * SEQ * 64, p.P + (size_t)b * SEQ * NINP + C_NVW, NINP, nullptr, wm, qf, qpos, 0.f, 0u, q0w, o); }
#pragma unroll
    for (int i = 0; i < 16; ++i) { out[0][i] += g2 * o[0][i]; out[1][i] += g2 * o[1][i]; }
    { int qq = qpos, hq = h; asm volatile("" : "+v"(qq), "+v"(hq));
      store_ot(p.O + blk((size_t)b * SEQ + qq, 512 + hd * 64, MTOK), out, hq); }
}

__global__ void __launch_bounds__(NTHR, 2) hybrid_fwd(Args A) {
    extern __shared__ __attribute__((aligned(16))) unsigned char lds_raw[];
    LAS unsigned char* lds = (LAS unsigned char*)lds_raw;
    cg::grid_group grid = cg::this_grid();
    volatile LAS unsigned* bst = (volatile LAS unsigned*)(lds + LDS_BYTES - 16);
    if (threadIdx.x < 4) bst[threadIdx.x] = 0u;
    __syncthreads();
    (void)xcd_barrier_post((unsigned*)(A.ws + WS_CTL), bst);
#define GBAR() do { XcdBarrier b_; { unsigned char* bp_ = A.ws; asm volatile("" : "+s"(bp_)); b_.bar = (unsigned*)(bp_ + WS_CTL); } b_.x = xb_xcc_id(); b_.st = (volatile LAS unsigned*)(lds + LDS_BYTES - 16); xcd_barrier(b_); } while (0)
    const int G = gridDim.x, bx = blockIdx.x;
    unsigned char* ws = A.ws;
    bf16_t* XB = (bf16_t*)(ws + WS_XB); float* SS = (float*)(ws + WS_SSP); bf16_t* R1 = (bf16_t*)(ws + WS_R1); bf16_t* OB = (bf16_t*)(ws + WS_O);
    prologue(A, lds);
    if (A.ws == nullptr) grid.sync();
    GBAR();
#pragma unroll
    for (int l = 0; l < DEPTH; ++l) {
        unsigned char* wl = ws + WS_W + (size_t)l * WL_STRIDE;
#pragma unroll
        for (int f = 0; f < 2; ++f) {
            if (f == 1) {
                {
                    pg8::Gemm g{XB, (const bf16_t*)(wl + WL_WIN), MTOK, NINP, DM}; pg8::StaticOrder S; S.init(MTOK, NINP, G, bx);
                    EpiProj E{R1, SS + (size_t)(3 * l + 1) * MTOK * 16, (float*)(ws + WS_FFB)};
                    pg8::gemm_phase<EpiProj, pg8::StaticOrder, true, true>(lds, g, S, E);
#if DUP == 5
                    GBAR(); pg8::gemm_phase<EpiProj, pg8::StaticOrder, true, true>(lds, g, S, E);
#endif
                }
                GBAR();
                {
                    const LP p = make_lp(A, l);
#if DUP == 2
                    for (int rep = 0; rep < 2; ++rep) {
#endif
                    {
                        unsigned* ctr = (unsigned*)(A.ws + WS_CTL) + 3584 + 64 * (2 + l);
                        volatile LAS unsigned* slot = (volatile LAS unsigned*)(lds + LDS_BYTES - 32);
                        for (;;) {
                            __syncthreads();
                            if (threadIdx.x == 0) slot[0] = atomicAdd(ctr, 1u);
                            __syncthreads();
                            int it = (int)slot[0];
                            if (it >= 256 + 512 + 1024 + 32) break;
                            if (it < 32) prep_scan(p, it, lds);
                            else if (it < 288) { it -= 32; prep_cmp(p, it >> 7, (it >> 2) & 31, it & 3, lds); }
                            else if (it < 800) { it -= 288; prep_gmlp(p, it >> 4, it & 15, lds); }
                            else { it -= 800; prep_tile(p, it >> 5, 64 * (it & 31), lds); }
                        }
                    }
#if DUP == 6
                    for (int it = bx; it < 1024; it += G) prep_tile(p, it >> 5, 64 * (it & 31), lds);
#endif
#if DUP == 7
                    for (int it = bx; it < 512; it += G) prep_gmlp(p, it >> 4, it & 15, lds);
#endif
#if DUP == 8
                    for (int it = bx; it < 256; it += G) prep_cmp(p, it >> 7, (it >> 2) & 31, it & 3, lds);
#endif
#if DUP == 2
                    GBAR(); }
#endif
                }
                GBAR();
                {
                    const LP p = make_lp(A, l);
#if DUP == 3
                    for (int rep = 0; rep < 2; ++rep) {
#endif
                    {
                        unsigned* ctr = (unsigned*)(A.ws + WS_CTL) + 3584 + 64 * l;
                        volatile LAS unsigned* slot = (volatile LAS unsigned*)(lds + LDS_BYTES - 32);
                        for (;;) {
                            __syncthreads();
                            if (threadIdx.x == 0) slot[0] = atomicAdd(ctr, 1u);
                            __syncthreads();
                            const int it = (int)slot[0];
                            if (it >= 2048) break;
                            if (it < 1024) nsa_unit(p, it & 31, 31 - (it >> 5), lds); else { const int fi = it - 1024; fox_unit(p, fi & 127, 7 - (fi >> 7), lds); }
                        }
                    }
#if DUP == 3
                    GBAR(); }
#endif
                }
                GBAR();
                {
                    pg8::Gemm g{OB, (const bf16_t*)(wl + WL_WOUT), MTOK, DM, DM}; pg8::StaticOrder S; S.init(MTOK, DM, G, bx);
                    EpiResid E{nullptr, nullptr, XB, SS + (size_t)(3 * l + 2) * MTOK * 16, 1.0f};
                    pg8::gemm_phase<EpiResid, pg8::StaticOrder, true, true>(lds, g, S, E);
                }
                GBAR();
            }
            {
                pg8::Gemm g{XB, (const bf16_t*)(wl + (f == 0 ? WL_W13A : WL_W13B)), MTOK, 2 * DFF, DM}; pg8::StaticOrder S; S.init(MTOK, 2 * DFF, G, bx);
                EpiSwiGLU E{R1, SS + (size_t)(3 * l + 2 * f) * MTOK * 16};
                pg8::gemm_phase<EpiSwiGLU, pg8::StaticOrder, true, true>(lds, g, S, E);
#if DUP == 4
                GBAR(); pg8::gemm_phase<EpiSwiGLU, pg8::StaticOrder, true, true>(lds, g, S, E);
#endif
#if DUP == 10
                GBAR(); { EpiNull E0{(float*)(ws + WS_R2)}; pg8::gemm_phase<EpiNull, pg8::StaticOrder, true, true>(lds, g, S, E0); }
#endif
            }
            GBAR();
            {
                pg8::Gemm g{R1, (const bf16_t*)(wl + (f == 0 ? WL_W2A : WL_W2B)), MTOK, DM, DFF}; pg8::StaticOrder S; S.init(MTOK, DM, G, bx);
                const bool last = (l == DEPTH - 1) && (f == 1);
                EpiResid E{(l == 0 && f == 0) ? A.in[0] : nullptr, last ? A.out : nullptr, XB, last ? nullptr : SS + (size_t)(3 * l + 1 + 2 * f) * MTOK * 16, 0.5f};
                pg8::gemm_phase<EpiResid, pg8::StaticOrder, true, true>(lds, g, S, E);
            }
            if (!(l == DEPTH - 1 && f == 1)) GBAR();
        }
    }
}

extern "C" void kernel_launch(void* const* d_in, const int* in_sizes, int n_in, void* d_out, int out_size, void* d_ws, size_t ws_size, hipStream_t stream) {
    static int grid = 0;
    if (grid == 0) {
        if (n_in != 31 || out_size != MTOK * DM || ws_size < WS_TOTAL) { fprintf(stderr, "kernel_launch: unexpected shapes (n_in %d out %d ws %zu)\n", n_in, out_size, ws_size); grid = -1; return; }
        int dev = 0, cus = 0, per_cu = 0;
        (void)hipGetDevice(&dev); (void)hipDeviceGetAttribute(&cus, hipDeviceAttributeMultiprocessorCount, dev);
        (void)hipFuncSetAttribute((const void*)hybrid_fwd, hipFuncAttributeMaxDynamicSharedMemorySize, LDS_BYTES);
        (void)hipOccupancyMaxActiveBlocksPerMultiprocessor(&per_cu, (const void*)hybrid_fwd, NTHR, LDS_BYTES);
        if (per_cu < 1) { fprintf(stderr, "kernel_launch: occupancy query says %d blocks per CU\n", per_cu); per_cu = 1; }
        (void)hipGetLastError();
        grid = cus * 1;
        if (grid <= 0) grid = 256;
    }
    if (grid < 0) return;
    if (hipMemsetAsync((char*)d_ws + WS_CTL, 0, WS_CTL_BYTES, stream) != hipSuccess) { fprintf(stderr, "kernel_launch: memset failed\n"); return; }
    Args a{};
    for (int i = 0; i < 31; ++i) a.in[i] = (const float*)d_in[i];
    a.out = (float*)d_out; a.ws = (unsigned char*)d_ws;
    void* params[] = {&a};
    hipError_t e = hipLaunchCooperativeKernel((const void*)hybrid_fwd, dim3(grid), dim3(NTHR), params, LDS_BYTES, stream);
    if (e != hipSuccess) fprintf(stderr, "kernel_launch: cooperative launch failed: %s (grid %d)\n", hipGetErrorString(e), grid);
}
```
